# Optimizing an MI355X kernel written in HIP

```python
import math
import jax, jax.numpy as jnp
from jax import lax
import numpy as np

D_MODEL = 2048
BATCH = 4
SEQ = 2048
DEPTH = 2

CHUNK = 64
Q_BLOCK = 128
N_A_LAYERS = DEPTH // 2
N_B_LAYERS = DEPTH - N_A_LAYERS
POOL_WINDOWS = (2, 4, 8, 16)
N_POOL_GROUPS = len(POOL_WINDOWS)
POOL_GROUP_DIM = D_MODEL // N_POOL_GROUPS
HEAD_DIM = 128
N_HEADS = D_MODEL // (2 * HEAD_DIM)
N_MAPS = 2 * N_HEADS
V_HEAD_DIM = 2 * HEAD_DIM
QK_WIDTH = N_MAPS * HEAD_DIM
V_WIDTH = N_HEADS * V_HEAD_DIM
D_FF = ((8 * D_MODEL // 3 + 255) // 256) * 256
NUM_BUCKETS = 32
MAX_DISTANCE = 128
RMS_EPS = 1e-6
SUBLN_EPS = 1e-5

kernel_name = "yoco_pool_diffattn_macaron_trunk"

F32 = jnp.float32


def rms_norm(x, g, eps=RMS_EPS):
    xf = x.astype(F32)
    y = xf * lax.rsqrt(jnp.mean(xf * xf, axis=-1, keepdims=True) + eps)
    return (y * g.astype(F32)).astype(x.dtype)


def swiglu(h, w_gate, w_up, w_down):
    return (jax.nn.silu(h @ w_gate) * (h @ w_up)) @ w_down


def rel_bucket(rel):
    half = NUM_BUCKETS // 2
    max_exact = half // 2
    ret = jnp.where(rel > 0, half, 0)
    n = jnp.abs(rel)
    nf = jnp.maximum(n, 1).astype(F32)
    large = max_exact + (jnp.log(nf / max_exact) / math.log(MAX_DISTANCE / max_exact)
                         * (half - max_exact)).astype(jnp.int32)
    large = jnp.minimum(large, half - 1)
    return ret + jnp.where(n < max_exact, n, large)


def pool_mixer(h, w, scale):
    B, S, _ = h.shape
    hg = h.reshape(B, S, N_POOL_GROUPS, POOL_GROUP_DIM)
    hf = hg.astype(F32)
    cs = lax.cumsum(hf, axis=1)
    t = jnp.arange(S)
    diffs = []
    for gi, win in enumerate(POOL_WINDOWS):
        c = cs[:, :, gi]
        c_prev = jnp.pad(c, ((0, 0), (win, 0), (0, 0)))[:, :S]
        cnt = jnp.minimum(t + 1, win).astype(F32)[None, :, None]
        diffs.append((c - c_prev) / cnt - hf[:, :, gi])
    d = jnp.stack(diffs, axis=2).astype(h.dtype)
    y = jnp.einsum('bsgc,gce->bsge', d, w).reshape(B, S, D_MODEL)
    return y * scale


def shared_kv(x, kv_norm, w_k, w_v):
    B, S, _ = x.shape
    hk = rms_norm(x, kv_norm)
    k = (hk @ w_k).reshape(B, S, N_HEADS, 2, HEAD_DIM)
    v = (hk @ w_v).reshape(B, S, N_HEADS, V_HEAD_DIM)
    return k, v


def diff_attention(h, w_q, w_o, lam, subln_g, k, v, rel_bias, lambda_init):
    B, S, _ = h.shape
    q = (h @ w_q).reshape(B, S, N_HEADS, 2, HEAD_DIM)
    lamf = lam.astype(F32)
    lam_full = (jnp.exp(jnp.sum(lamf[0] * lamf[1])) - jnp.exp(jnp.sum(lamf[2] * lamf[3]))
                + lambda_init)
    scale = HEAD_DIM ** -0.5
    table = rel_bias.astype(F32)
    pos = jnp.arange(S)
    outs = []
    for blk in range(S // Q_BLOCK):
        q0 = blk * Q_BLOCK
        kend = q0 + Q_BLOCK
        qb = q[:, q0:kend]
        kb = k[:, :kend]
        vb = v[:, :kend]
        qpos = pos[q0:kend]
        kpos = pos[:kend]
        s = jnp.einsum('bqhcd,bkhcd->bhcqk', qb, kb, preferred_element_type=F32) * scale
        bias = table[rel_bucket(kpos[None, :] - qpos[:, None])]
        bias = jnp.transpose(bias, (2, 0, 1)).reshape(N_HEADS, 2, Q_BLOCK, kend)
        allowed = (kpos[None, :] // CHUNK) <= (qpos[:, None] // CHUNK)
        s = jnp.where(allowed, s + bias, -jnp.inf)
        p = jax.nn.softmax(s, axis=-1)
        a = p[:, :, 0] - lam_full * p[:, :, 1]
        o = jnp.einsum('bhqk,bkhd->bqhd', a, vb.astype(F32))
        o = o * lax.rsqrt(jnp.mean(o * o, axis=-1, keepdims=True) + SUBLN_EPS)
        o = o * subln_g.astype(F32) * (1.0 - lambda_init)
        outs.append(o)
    o = jnp.concatenate(outs, axis=1).reshape(B, S, V_WIDTH).astype(h.dtype)
    return o @ w_o


def setup_inputs(seed: int = 0) -> dict:
    key = jax.random.key(seed)
    ks = jax.random.split(key, 16)
    nrm = jax.random.normal
    x = nrm(ks[0], (BATCH, SEQ, D_MODEL), F32)
    norm_gains = 1.0 + 0.02 * nrm(ks[1], (DEPTH, 3, 2, D_MODEL), F32)
    ffn_w_gate = nrm(ks[2], (DEPTH, 2, D_MODEL, D_FF), F32) * D_MODEL ** -0.5
    ffn_w_up = nrm(ks[3], (DEPTH, 2, D_MODEL, D_FF), F32) * D_MODEL ** -0.5
    ffn_w_down = nrm(ks[4], (DEPTH, 2, D_FF, D_MODEL), F32) * D_FF ** -0.5
    pool_w = nrm(ks[5], (N_A_LAYERS, N_POOL_GROUPS, POOL_GROUP_DIM, POOL_GROUP_DIM), F32) * POOL_GROUP_DIM ** -0.5
    pool_scale = 1.0 + 0.02 * nrm(ks[6], (N_A_LAYERS, D_MODEL), F32)
    kv_norm = 1.0 + 0.02 * nrm(ks[7], (D_MODEL,), F32)
    w_k = nrm(ks[8], (D_MODEL, QK_WIDTH), F32) * D_MODEL ** -0.5
    w_v = nrm(ks[9], (D_MODEL, V_WIDTH), F32) * D_MODEL ** -0.5
    rel_bias = 0.5 * nrm(ks[10], (NUM_BUCKETS, N_MAPS), F32)
    w_q = nrm(ks[11], (N_B_LAYERS, D_MODEL, QK_WIDTH), F32) * D_MODEL ** -0.5
    w_o = nrm(ks[12], (N_B_LAYERS, V_WIDTH, D_MODEL), F32) * V_WIDTH ** -0.5
    lambdas = 0.1 * nrm(ks[13], (N_B_LAYERS, 4, HEAD_DIM), F32)
    subln_gain = 1.0 + 0.02 * nrm(ks[14], (N_B_LAYERS, V_HEAD_DIM), F32)
    return {"x": x, "norm_gains": norm_gains, "ffn_w_gate": ffn_w_gate, "ffn_w_up": ffn_w_up,
            "ffn_w_down": ffn_w_down, "pool_w": pool_w, "pool_scale": pool_scale,
            "kv_norm": kv_norm, "w_k": w_k, "w_v": w_v, "rel_bias": rel_bias,
            "w_q": w_q, "w_o": w_o, "lambdas": lambdas, "subln_gain": subln_gain}


def reference(x, norm_gains, ffn_w_gate, ffn_w_up, ffn_w_down, pool_w, pool_scale,
              kv_norm, w_k, w_v, rel_bias, w_q, w_o, lambdas, subln_gain):
    k = v = None
    for l in range(DEPTH):
        g = norm_gains[l]
        if l == N_A_LAYERS:
            k, v = shared_kv(x, kv_norm, w_k, w_v)
        h = rms_norm(x, g[0, 0])
        x = x + 0.5 * rms_norm(swiglu(h, ffn_w_gate[l, 0], ffn_w_up[l, 0], ffn_w_down[l, 0]), g[0, 1])
        h = rms_norm(x, g[1, 0])
        if l < N_A_LAYERS:
            m = pool_mixer(h, pool_w[l], pool_scale[l])
        else:
            j = l - N_A_LAYERS
            lambda_init = 0.8 - 0.6 * math.exp(-0.3 * l)
            m = diff_attention(h, w_q[j], w_o[j], lambdas[j], subln_gain[j], k, v, rel_bias, lambda_init)
        x = x + rms_norm(m, g[1, 1])
        h = rms_norm(x, g[2, 0])
        x = x + 0.5 * rms_norm(swiglu(h, ffn_w_gate[l, 1], ffn_w_up[l, 1], ffn_w_down[l, 1]), g[2, 1])
    return x
```

```cpp
#include <hip/hip_runtime.h>
#include <hip/hip_cooperative_groups.h>
#include <cstdio>
#include <cstdint>
namespace cg = cooperative_groups;

#ifndef MK_MULTI
#define MK_MULTI 0
#endif

#ifndef DUP_MASK
#define DUP_MASK 0u
#endif

#define LAS __attribute__((address_space(3)))
#define GAS __attribute__((address_space(1)))
typedef unsigned short bf16_t;
typedef short bf16x8 __attribute__((ext_vector_type(8)));
typedef float f32x4 __attribute__((ext_vector_type(4)));
typedef float f32x2 __attribute__((ext_vector_type(2)));
typedef unsigned u32x4 __attribute__((ext_vector_type(4)));
typedef unsigned u32x2 __attribute__((ext_vector_type(2)));

constexpr int D = 2048, BATCH = 4, SEQ = 2048, M = BATCH * SEQ, DFF = 5632, NH = 8;
constexpr float RMS_EPS = 1e-6f, SUBLN_EPS = 1e-5f;
constexpr float LAMBDA_INIT = 0.35550906759f;
constexpr float LOG2E = 1.44269504089f;
constexpr float QSCALE = 0.08838834764831845f * LOG2E;

constexpr size_t SZ_WGU = (size_t)2 * DFF * D * 2, SZ_WD = (size_t)D * DFF * 2, SZ_SQ = (size_t)D * D * 2, SZ_ACT = (size_t)M * DFF * 2, SZ_MD2 = (size_t)M * D * 2;
constexpr size_t WS_WGU = 0;
constexpr size_t WS_WD = WS_WGU + 4 * SZ_WGU;
constexpr size_t WS_POOL = WS_WD + 4 * SZ_WD;
constexpr size_t WS_WK = WS_POOL + (size_t)D * 512 * 2;
constexpr size_t WS_WV = WS_WK + SZ_SQ, WS_WQ = WS_WV + SZ_SQ, WS_WO = WS_WQ + SZ_SQ;
constexpr size_t WS_XN = WS_WO + SZ_SQ;
constexpr size_t WS_ACT = WS_XN + SZ_MD2;
constexpr size_t WS_DP = WS_ACT, WS_Q = WS_ACT, WS_O = WS_ACT + SZ_MD2;
constexpr size_t WS_Y = WS_ACT + SZ_ACT;
constexpr size_t WS_K = WS_Y + (size_t)M * D * 4;
constexpr size_t WS_VT = WS_K + SZ_MD2;
constexpr size_t WS_LUT = WS_VT + SZ_MD2;
constexpr size_t WS_BAR = WS_LUT + 16 * 256 * 4 + 256;
constexpr size_t BAR_BYTES = 65536;
constexpr size_t WS_SLOTS = WS_BAR + BAR_BYTES;
constexpr size_t SZ_SLOT = (size_t)M * 8 * 4;
constexpr size_t WS_END = WS_SLOTS + 13 * SZ_SLOT;

constexpr int RING_BYTES = 131072, LUT_OFF = RING_BYTES, RST_OFF = RING_BYTES  , MISC_OFF = RING_BYTES + 4096, LDS_BYTES = 147456;
constexpr int NWAVES = 8;

namespace pg8 {
constexpr int BM = 256, BK = 64, HALF = 128, HTB = HALF * BK * 2, NXCD = 8, WGM = 8;
__host__ __device__ __forceinline__ int lds_byte(int r, int c) { const int st = (r >> 4) * 2 + (c >> 5), rr = r & 15, cc = c & 31, ob = rr * 64 + cc * 2; return st * 1024 + (ob ^ (((ob >> 9) & 1) << 5)); }
__host__ __device__ __forceinline__ void stage_rc(int b, int& R, int& C) { const int st = b / 1024, sb = b % 1024, swz = sb ^ (((sb >> 9) & 1) << 5); R = (st >> 1) * 16 + swz / 64; C = (st & 1) * 32 + (swz % 64) / 2; }
__host__ __device__ __forceinline__ int perm32(int rho) { const int n = rho >> 4, i = rho & 15; return 8 * (i >> 2) + 4 * n + (i & 3); }

struct Unit { int pm, pn; };
struct Gemm { const bf16_t* A; const bf16_t* Bt; int M, N, K, lda, ldb, agrp; };

struct StaticOrder {
    int nM, nN, nwg, G, c;
    __host__ __device__ void init(int M_, int N_, int G_, int c_) { nM = M_ / BM; nN = N_ / BM; nwg = nM * nN; G = G_; c = c_; }
    __host__ __device__ bool next(int i, Unit& u) const {
        const long L = (long)i * G + c; if (L >= nwg) return false;
        int wgid = (int)L; { const int q = nwg / NXCD, r = nwg % NXCD, xcd = wgid % NXCD, off = wgid / NXCD; wgid = (xcd < r ? xcd * (q + 1) : r * (q + 1) + (xcd - r) * q) + off; }
        const int nig = WGM * nN, gid = wgid / nig, fm = gid * WGM, gsz = (nM - fm) < WGM ? (nM - fm) : WGM;
        u.pm = fm + ((wgid % nig) % gsz); u.pn = (wgid % nig) / gsz; return true;
    }
};

__device__ __forceinline__ unsigned cvt_pk_bf16(float lo, float hi) { unsigned r; asm volatile("v_cvt_pk_bf16_f32 %0, %1, %2" : "=v"(r) : "v"(lo), "v"(hi)); return r; }

struct EpiF32 {
    static constexpr bool PERM = false, AFTER_DRAIN = false; static constexpr int RS = 0;
    float* C; int ldc; const float* rsl;
    __device__ __forceinline__ void operator()(const f32x4 (&acc)[2][2][4][2], const Unit& u, int wr, int wc, int fr, int fq, const LAS float* T) const {
        const int row0 = u.pm * BM + wr * 64 + fr, col0 = u.pn * BM + wc * 32 + 4 * fq;
#pragma unroll
        for (int ai = 0; ai < 2; ++ai)
#pragma unroll
            for (int m = 0; m < 4; ++m) { float* rowp = C + (size_t)(row0 + ai * HALF + m * 16) * ldc + col0;
#pragma unroll
                for (int bj = 0; bj < 2; ++bj)
#pragma unroll
                    for (int n = 0; n < 2; ++n) *(f32x4*)(rowp + bj * HALF + n * 16) = acc[ai][bj][m][n]; }
    }
};
template <int RS_>
struct EpiBf16 {
    static constexpr bool PERM = true, AFTER_DRAIN = false; static constexpr int RS = RS_;
    bf16_t* O; int ldc; float scale; const float* rsl;
    __device__ __forceinline__ void operator()(const f32x4 (&acc)[2][2][4][2], const Unit& u, int wr, int wc, int fr, int fq, const LAS float* T) const {
        const int row0 = u.pm * BM + wr * 64 + fr, col0 = u.pn * BM + wc * 32 + 8 * fq;
        f32x4 cs[2][2];
#pragma unroll
        for (int bj = 0; bj < 2; ++bj)
#pragma unroll
            for (int n = 0; n < 2; ++n) cs[bj][n] = (RS_ == 2) ? *(const LAS f32x4*)(T + bj * HALF + wc * 32 + 8 * fq + 4 * n) * scale : (f32x4){scale, scale, scale, scale};
#pragma unroll
        for (int ai = 0; ai < 2; ++ai)
#pragma unroll
            for (int m = 0; m < 4; ++m) { bf16_t* rowp = O + (size_t)(row0 + ai * HALF + m * 16) * ldc + col0; const float rsr = (RS_ == 1) ? T[ai * HALF + wr * 64 + m * 16 + fr] : 1.0f;
#pragma unroll
                for (int bj = 0; bj < 2; ++bj) { const f32x4 v0 = acc[ai][bj][m][0] * cs[bj][0] * rsr, v1 = acc[ai][bj][m][1] * cs[bj][1] * rsr;
                    u32x4 w; w.x = cvt_pk_bf16(v0[0], v0[1]); w.y = cvt_pk_bf16(v0[2], v0[3]); w.z = cvt_pk_bf16(v1[0], v1[1]); w.w = cvt_pk_bf16(v1[2], v1[3]);
                    *(u32x4*)(rowp + bj * HALF) = w; } }
    }
};
__device__ __forceinline__ f32x2 silu_mul2(f32x2 g, f32x2 u) {
    const f32x2 t = g * (-LOG2E); f32x2 e; e.x = __builtin_amdgcn_exp2f(t.x); e.y = __builtin_amdgcn_exp2f(t.y);
    const f32x2 d = e + 1.0f; f32x2 r; r.x = __builtin_amdgcn_rcpf(d.x); r.y = __builtin_amdgcn_rcpf(d.y);
    return (g * u) * r;
}
struct EpiSwiGLU {
    static constexpr bool PERM = true, AFTER_DRAIN = false; static constexpr int RS = 1;
    bf16_t* O; int ldc; const float* rsl;
    __device__ __forceinline__ void operator()(const f32x4 (&acc)[2][2][4][2], const Unit& u, int wr, int wc, int fr, int fq, const LAS float* T) const {
        const int row0 = u.pm * BM + wr * 64 + fr, col0 = u.pn * HALF + wc * 32 + 8 * fq;
#pragma unroll
        for (int ai = 0; ai < 2; ++ai)
#pragma unroll
            for (int m = 0; m < 4; ++m) { bf16_t* rowp = O + (size_t)(row0 + ai * HALF + m * 16) * ldc + col0;
                const float rsr = T[ai * HALF + wr * 64 + m * 16 + fr];
                const f32x4 g0 = acc[ai][0][m][0] * rsr, g1 = acc[ai][0][m][1] * rsr, u0 = acc[ai][1][m][0] * rsr, u1 = acc[ai][1][m][1] * rsr;
                const f32x2 a0 = silu_mul2((f32x2){g0[0], g0[1]}, (f32x2){u0[0], u0[1]}), a1 = silu_mul2((f32x2){g0[2], g0[3]}, (f32x2){u0[2], u0[3]});
                const f32x2 a2 = silu_mul2((f32x2){g1[0], g1[1]}, (f32x2){u1[0], u1[1]}), a3 = silu_mul2((f32x2){g1[2], g1[3]}, (f32x2){u1[2], u1[3]});
                u32x4 w; w.x = cvt_pk_bf16(a0.x, a0.y); w.y = cvt_pk_bf16(a1.x, a1.y); w.z = cvt_pk_bf16(a2.x, a2.y); w.w = cvt_pk_bf16(a3.x, a3.y);
                *(u32x4*)rowp = w; }
    }
};

#ifndef PG8_SP2
#define PG8_SP2 true
#endif
__device__ __forceinline__ void build_rs_table(LAS unsigned char* lds, const float* rsl, int panel) {
    LAS float* T = (LAS float*)(lds + RST_OFF);
    if (threadIdx.x < 256) { const f32x4* sp = (const f32x4*)(rsl + (size_t)(panel * 256 + (int)threadIdx.x) * 8); const f32x4 a = sp[0], b = sp[1];
        const float t = ((a.x + a.y) + (a.z + a.w)) + ((b.x + b.y) + (b.z + b.w)); T[threadIdx.x] = 1.0f / sqrtf(t * (1.0f / D) + RMS_EPS); }
    asm volatile("s_waitcnt lgkmcnt(0)" ::: "memory"); __syncthreads();
}
template <class Epi, class Sched, bool ALIGN_EPI = true, bool SP2 = PG8_SP2>
__device__ __forceinline__ void gemm_phase(LAS unsigned char* lds, const Gemm g, const Sched& S, const Epi& E) {
    static_assert(Epi::RS == 0 || ALIGN_EPI, "the row-scale table rebuild needs the aligned epilogue");
    const int tid = threadIdx.x, wid = __builtin_amdgcn_readfirstlane(tid >> 6), lane = tid & 63, wr = wid >> 2, wc = wid & 3, fr = lane & 15, fq = lane >> 4;
    const int K = g.K, nt = K / BK;
    unsigned voffA[2], voffB[2];
#pragma unroll
    for (int i = 0; i < 2; ++i) { const int R = i * 64 + wid * 8 + (lane >> 3), C = (((lane & 7) ^ ((R >> 1) & 7)) * 8); const int Rb = Epi::PERM ? ((R & ~31) + perm32(R & 31)) : R;
        voffA[i] = (unsigned)(R * g.lda + C) * 2u; voffB[i] = (unsigned)(Rb * g.ldb + C) * 2u; }
    const size_t kstep = (size_t)(BK * 2);
    const size_t hstepA = (size_t)HALF * g.lda * 2, hstepB = (size_t)HALF * g.ldb * 2;
    const size_t tstepA = 2 * hstepA, tstepB = 2 * hstepB;
    const unsigned ldsw = (unsigned)wid * 1024u;
    const int sw = (fr >> 1) & 7;
    const int aoff0 = (wr * 64 + fr) * 128 + ((fq ^ sw) * 16), aoff1 = (wr * 64 + fr) * 128 + (((4 + fq) ^ sw) * 16);
    const int boff0 = (wc * 32 + fr) * 128 + ((fq ^ sw) * 16), boff1 = (wc * 32 + fr) * 128 + (((4 + fq) ^ sw) * 16);
#define PG8_SA(b, h) (((b) * 2 + (h)) * HTB)
#define PG8_SB(b, h) ((4 + (b) * 2 + (h)) * HTB)
#define PG8_STAGE(bufoff, gbase, voff) do { _Pragma("unroll") for (int _i = 0; _i < 2; ++_i) \
        __builtin_amdgcn_global_load_lds((const unsigned*)((const char*)(gbase) + (voff)[_i]), (LAS unsigned*)(lds + (bufoff) + ldsw + _i * 8192), 16, 0, 0); } while (0)
#define PG8_LDA(dst, b, h) do { _Pragma("unroll") for (int m = 0; m < 4; ++m) _Pragma("unroll") for (int k = 0; k < 2; ++k) dst[m][k] = *(const LAS bf16x8*)(lds + PG8_SA(b, h) + (k ? aoff1 : aoff0) + m * 2048); } while (0)
#define PG8_LDB(dst, b, h) do { _Pragma("unroll") for (int n = 0; n < 2; ++n) _Pragma("unroll") for (int k = 0; k < 2; ++k) dst[n][k] = *(const LAS bf16x8*)(lds + PG8_SB(b, h) + (k ? boff1 : boff0) + n * 2048); } while (0)
#define PG8_MMA(ai, bj, At, Bt) do { __builtin_amdgcn_s_setprio(1); _Pragma("unroll") for (int m = 0; m < 4; ++m) _Pragma("unroll") for (int n = 0; n < 2; ++n) _Pragma("unroll") for (int k = 0; k < 2; ++k) \
        acc[ai][bj][m][n] = __builtin_amdgcn_mfma_f32_16x16x32_bf16(Bt[n][k], At[m][k], acc[ai][bj][m][n], 0, 0, 0); __builtin_amdgcn_s_setprio(0); } while (0)
#define PG8_WAIT_V(n) asm volatile("s_waitcnt vmcnt(" #n ")" ::: "memory")
#define PG8_WAIT_L(n) asm volatile("s_waitcnt lgkmcnt(" #n ")" ::: "memory")
#define PG8_BAR __builtin_amdgcn_s_barrier()
#define PG8_SCHED __builtin_amdgcn_sched_barrier(0)
#define PG8_AOFF(u) ((size_t)(u).pm * tstepA + (g.agrp ? (size_t)((u).pn >> 1) * 1024 : (size_t)0))
    Unit cur, nxt; int ui = 0;
    if (!S.next(0, cur)) return;
    const LAS float* T = (const LAS float*)(lds + RST_OFF); int tpanel = -1;
    f32x4 acc[2][2][4][2];
#pragma unroll
    for (int a = 0; a < 2; ++a)
#pragma unroll
        for (int b = 0; b < 2; ++b)
#pragma unroll
            for (int m = 0; m < 4; ++m)
#pragma unroll
                for (int n = 0; n < 2; ++n) acc[a][b][m][n] = (f32x4){0.f, 0.f, 0.f, 0.f};
    bf16x8 At[4][2], B0[2][2], B1[2][2];
    const char* cA = (const char*)g.A + PG8_AOFF(cur); const char* cB = (const char*)g.Bt + (size_t)cur.pn * tstepB;
    if constexpr (SP2) {
    PG8_STAGE(PG8_SB(0, 0), cB, voffB); PG8_STAGE(PG8_SB(0, 1), cB + hstepB, voffB); PG8_STAGE(PG8_SA(0, 0), cA, voffA); PG8_STAGE(PG8_SA(0, 1), cA + hstepA, voffA);
    if constexpr (Epi::RS != 0) { tpanel = Epi::RS == 1 ? cur.pm : cur.pn; build_rs_table(lds, E.rsl, tpanel); }
    if (wr == 1) PG8_BAR;
    PG8_WAIT_V(2); PG8_BAR;
    PG8_STAGE(PG8_SB(1, 0), cB + kstep, voffB); PG8_STAGE(PG8_SA(1, 0), cA + kstep, voffA); PG8_STAGE(PG8_SB(1, 1), cB + hstepB + kstep, voffB);
    PG8_WAIT_V(6); PG8_BAR;
    } else {
    PG8_STAGE(PG8_SB(0, 0), cB, voffB); PG8_STAGE(PG8_SA(0, 0), cA, voffA); PG8_STAGE(PG8_SB(0, 1), cB + hstepB, voffB); PG8_STAGE(PG8_SA(0, 1), cA + hstepA, voffA);
    if (wr == 1) PG8_BAR;
    PG8_WAIT_V(4); PG8_BAR;
    PG8_STAGE(PG8_SB(1, 0), cB + kstep, voffB); PG8_STAGE(PG8_SA(1, 0), cA + kstep, voffA); PG8_STAGE(PG8_SB(1, 1), cB + hstepB + kstep, voffB);
    PG8_WAIT_V(6); PG8_BAR;
    }
    for (;;) {
        const bool has_next = S.next(ui + 1, nxt);
        const char* nA = has_next ? (const char*)g.A + PG8_AOFF(nxt) : cA; const char* nB = has_next ? (const char*)g.Bt + (size_t)nxt.pn * tstepB : cB;
        for (int t = 0; t < nt; t += 2) {
            const bool last = (t == nt - 2);
            const char* a1 = cA + (size_t)(t + 1) * kstep;
            const char* a2 = last ? nA : cA + (size_t)(t + 2) * kstep; const char* b2 = last ? nB : cB + (size_t)(t + 2) * kstep;
            const char* a3 = a2 + kstep; const char* b3 = b2 + kstep;
            if constexpr (SP2) {
            PG8_LDB(B0, 0, 0); PG8_LDB(B1, 0, 1); PG8_SCHED; PG8_LDA(At, 0, 0); PG8_STAGE(PG8_SA(1, 1), a1 + hstepA, voffA);
            PG8_WAIT_V(8); PG8_WAIT_L(0); PG8_BAR; PG8_MMA(0, 0, At, B0); PG8_MMA(0, 1, At, B1); PG8_BAR; PG8_SCHED;
            PG8_LDA(At, 0, 1); PG8_STAGE(PG8_SB(0, 0), b2, voffB); PG8_STAGE(PG8_SB(0, 1), b2 + hstepB, voffB); PG8_STAGE(PG8_SA(0, 0), a2, voffA);
            PG8_WAIT_V(8); PG8_WAIT_L(0); PG8_BAR; PG8_MMA(1, 0, At, B0); PG8_MMA(1, 1, At, B1); PG8_BAR; PG8_SCHED;
            PG8_LDB(B0, 1, 0); PG8_LDB(B1, 1, 1); PG8_SCHED; PG8_LDA(At, 1, 0); PG8_STAGE(PG8_SA(0, 1), a2 + hstepA, voffA);
            PG8_WAIT_V(8); PG8_WAIT_L(0); PG8_BAR; PG8_MMA(0, 0, At, B0); PG8_MMA(0, 1, At, B1); PG8_BAR; PG8_SCHED;
            PG8_LDA(At, 1, 1); PG8_STAGE(PG8_SB(1, 0), b3, voffB); PG8_STAGE(PG8_SB(1, 1), b3 + hstepB, voffB); PG8_STAGE(PG8_SA(1, 0), a3, voffA);
            PG8_WAIT_V(8); PG8_WAIT_L(0); PG8_BAR; PG8_MMA(1, 0, At, B0); PG8_MMA(1, 1, At, B1); PG8_BAR; PG8_SCHED;
            } else {
            PG8_LDB(B0, 0, 0); PG8_SCHED; PG8_LDA(At, 0, 0); PG8_STAGE(PG8_SA(1, 1), a1 + hstepA, voffA);
            PG8_WAIT_L(8); PG8_BAR; PG8_WAIT_L(0); PG8_MMA(0, 0, At, B0); PG8_BAR; PG8_SCHED;
            PG8_LDB(B1, 0, 1); PG8_STAGE(PG8_SB(0, 0), b2, voffB);
            PG8_BAR; PG8_WAIT_L(0); PG8_MMA(0, 1, At, B1); PG8_BAR;
            PG8_LDA(At, 0, 1); PG8_STAGE(PG8_SA(0, 0), a2, voffA);
            PG8_BAR; PG8_WAIT_L(0); PG8_MMA(1, 0, At, B0); PG8_BAR; PG8_SCHED;
            PG8_STAGE(PG8_SB(0, 1), b2 + hstepB, voffB);
            PG8_WAIT_V(6); PG8_BAR; PG8_MMA(1, 1, At, B1); PG8_BAR;
            PG8_LDB(B0, 1, 0); PG8_SCHED; PG8_LDA(At, 1, 0); PG8_STAGE(PG8_SA(0, 1), a2 + hstepA, voffA);
            PG8_WAIT_L(8); PG8_BAR; PG8_WAIT_L(0); PG8_MMA(0, 0, At, B0); PG8_BAR; PG8_SCHED;
            PG8_LDB(B1, 1, 1); PG8_STAGE(PG8_SB(1, 0), b3, voffB);
            PG8_BAR; PG8_WAIT_L(0); PG8_MMA(0, 1, At, B1); PG8_BAR;
            PG8_LDA(At, 1, 1); PG8_STAGE(PG8_SA(1, 0), a3, voffA);
            PG8_BAR; PG8_WAIT_L(0); PG8_MMA(1, 0, At, B0); PG8_BAR; PG8_SCHED;
            PG8_STAGE(PG8_SB(1, 1), b3 + hstepB, voffB);
            PG8_WAIT_V(6); PG8_BAR; PG8_MMA(1, 1, At, B1); PG8_BAR;
            }
        }
        if constexpr (ALIGN_EPI) { if (wr == 0) PG8_BAR; }
        if constexpr (Epi::RS != 0) { const int p = Epi::RS == 1 ? cur.pm : cur.pn;
            if (p != tpanel) { __syncthreads(); build_rs_table(lds, E.rsl, p); tpanel = p; } }
        if constexpr (!Epi::AFTER_DRAIN) E(acc, cur, wr, wc, fr, fq, T);
        if (!has_next) break;
#pragma unroll
        for (int a = 0; a < 2; ++a)
#pragma unroll
            for (int b = 0; b < 2; ++b)
#pragma unroll
                for (int m = 0; m < 4; ++m)
#pragma unroll
                    for (int n = 0; n < 2; ++n) acc[a][b][m][n] = (f32x4){0.f, 0.f, 0.f, 0.f};
        cur = nxt; cA = nA; cB = nB; ++ui;
        if constexpr (ALIGN_EPI) { if (wr == 1) PG8_BAR; }
    }
    PG8_WAIT_V(0);
    if constexpr (!ALIGN_EPI) { if (wr == 0) PG8_BAR; }
    PG8_BAR;
    if constexpr (Epi::AFTER_DRAIN) E.fused(acc, cur, wr, wc, fr, fq, lds);
#undef PG8_SA
#undef PG8_SB
#undef PG8_STAGE
#undef PG8_LDA
#undef PG8_LDB
#undef PG8_MMA
#undef PG8_AOFF
}
}

#define LDS_WAIT() asm volatile("s_waitcnt lgkmcnt(0)" ::: "memory")
#define VM_WAIT() asm volatile("s_waitcnt vmcnt(0)" ::: "memory")
__device__ __forceinline__ unsigned f2bf(float f) { unsigned u = __builtin_bit_cast(unsigned, f); return (u + 0x7fffu + ((u >> 16) & 1u)) >> 16; }
__device__ __forceinline__ unsigned pk2(float lo, float hi) { return f2bf(lo) | (f2bf(hi) << 16); }
__device__ __forceinline__ float bf2f(unsigned short b) { return __builtin_bit_cast(float, (unsigned)b << 16); }
__device__ __forceinline__ float wave_sum(float v) {
#pragma unroll
    for (int o = 1; o < 64; o <<= 1) v += __shfl_xor(v, o);
    return v;
}

#define XB_TMO      128
#define XB_XCNT(j)  (256  + 64 * (j))
#define XB_XSUB(j)  (1280 + 64 * (j))
#define XB_XGEN(j)  (2304 + 64 * (j))
#define XB_TOP      3328
#define XB_TOPGEN   3392
#define XCD_BAR_WORDS 3456
#define XB_SPIN_CAP (1u << 22)
__device__ __forceinline__ unsigned xb_ld(unsigned* p)              { return __hip_atomic_load(p, __ATOMIC_RELAXED, __HIP_MEMORY_SCOPE_AGENT); }
__device__ __forceinline__ unsigned xb_add(unsigned* p, unsigned v) { return __hip_atomic_fetch_add(p, v, __ATOMIC_RELAXED, __HIP_MEMORY_SCOPE_AGENT); }
__device__ __forceinline__ unsigned xb_xcc_id() { return (unsigned)__builtin_amdgcn_s_getreg((3 << 11) | 20) & 0xFu; }
#define XB_SPIN(cond, bar) do { unsigned _sp = 0; while (cond) { __builtin_amdgcn_s_sleep(1); \
    if ((++_sp & 255u) == 0u) { if (xb_ld(&(bar)[XB_TMO])) break; if (_sp > XB_SPIN_CAP) { atomicAdd(&(bar)[XB_TMO], 1u); break; } } } } while (0)
struct XcdBarrier { unsigned* bar; unsigned x; volatile LAS unsigned* st; };
__device__ __forceinline__ XcdBarrier xcd_barrier_post(unsigned* bar, volatile LAS unsigned* st) {
    XcdBarrier b; b.bar = bar; b.x = xb_xcc_id(); b.st = st;
    if (threadIdx.x == 0) (void)xb_add(&bar[XB_XCNT(b.x)], 1u);
    return b;
}
__device__ __forceinline__ void xcd_barrier_complete(unsigned* bar, unsigned x, unsigned& nloc, unsigned& nx) {
    const unsigned G = gridDim.x * gridDim.y * gridDim.z;
    unsigned sum, cnt, mine, sp = 0u;
    for (;;) {
        sum = 0u; cnt = 0u; mine = 0u;
#pragma unroll
        for (unsigned j = 0; j < 16; ++j) { const unsigned c = xb_ld(&bar[XB_XCNT(j)]); sum += c; cnt += (c > 0u) ? 1u : 0u; mine = (j == x) ? c : mine; }
        if (sum == G) break;
        __builtin_amdgcn_s_sleep(1);
        if ((++sp & 255u) == 0u) { if (xb_ld(&bar[XB_TMO])) break; if (sp > XB_SPIN_CAP) { atomicAdd(&bar[XB_TMO], 1u); break; } }
    }
    nloc = mine > 0u ? mine : 1u; nx = cnt > 0u ? cnt : 1u;
}
__device__ __forceinline__ void xcd_barrier(const XcdBarrier& b) {
    asm volatile("s_waitcnt vmcnt(0)" ::: "memory");
    __syncthreads();
    if (threadIdx.x == 0) {
        unsigned* bar = b.bar;
        __builtin_amdgcn_s_waitcnt(0);
        unsigned nloc = b.st[0], nx = b.st[1];
        if (nloc == 0u) { xcd_barrier_complete(bar, b.x, nloc, nx); b.st[0] = nloc; b.st[1] = nx; }
        const unsigned old = xb_add(&bar[XB_XSUB(b.x)], 1u);
        const unsigned gen = old / nloc;
        if (old + 1u == (gen + 1u) * nloc) {
            __builtin_amdgcn_fence(__ATOMIC_RELEASE, "agent");
            asm volatile("s_waitcnt vmcnt(0)" ::: "memory");
            const unsigned og = xb_add(&bar[XB_TOP], 1u);
            const unsigned tg = og / nx;
            if (og + 1u == (tg + 1u) * nx) xb_add(&bar[XB_TOPGEN], 1u);
            else XB_SPIN(xb_ld(&bar[XB_TOPGEN]) == tg, bar);
            __builtin_amdgcn_fence(__ATOMIC_ACQUIRE, "agent");
            xb_add(&bar[XB_XGEN(b.x)], 1u);
            asm volatile("s_waitcnt vmcnt(0)" ::: "memory");
        } else {
            XB_SPIN(xb_ld(&bar[XB_XGEN(b.x)]) == gen, bar);
            __builtin_amdgcn_fence(__ATOMIC_ACQUIRE, "agent");
            asm volatile("s_waitcnt vmcnt(0)" ::: "memory");
        }
    }
    __syncthreads();
}

__device__ __forceinline__ void grid_barrier(unsigned char* ws, LAS unsigned char* lds) {
    XcdBarrier b; b.bar = (unsigned*)(ws + WS_BAR); b.x = xb_xcc_id(); b.st = (volatile LAS unsigned*)(lds + MISC_OFF); xcd_barrier(b);
}
struct EpiNormRes {
    static constexpr bool PERM = true, AFTER_DRAIN = true; static constexpr int RS = 0;
    const float* x; float* xout; const float* norm_gains; unsigned char* ws; int idx, goff, first, last; float coef;
    __device__ __forceinline__ void rowstat(const f32x4 (&acc)[2][2][4][2], const pg8::Unit& u, int wr, int wc, int fr, int fq, LAS unsigned char* lds, float* slots) const {
        LAS float* P = (LAS float*)lds;
#pragma unroll
        for (int ai = 0; ai < 2; ++ai)
#pragma unroll
            for (int m = 0; m < 4; ++m) { float s = 0.f;
#pragma unroll
                for (int bj = 0; bj < 2; ++bj)
#pragma unroll
                    for (int n = 0; n < 2; ++n) { const f32x4 v = acc[ai][bj][m][n]; s += (v.x * v.x + v.y * v.y) + (v.z * v.z + v.w * v.w); }
                s += __shfl_xor(s, 16); s += __shfl_xor(s, 32);
                if (fq == 0) P[(ai * 128 + wr * 64 + m * 16 + fr) * 4 + wc] = s; }
        LDS_WAIT(); __syncthreads();
        if (slots && threadIdx.x < 256) { const f32x4 p = *(const LAS f32x4*)(P + threadIdx.x * 4); slots[(size_t)(u.pm * 256 + threadIdx.x) * 8 + u.pn] = (p.x + p.y) + (p.z + p.w); }
    }
    __device__ __forceinline__ void rowrs(const pg8::Unit& u, LAS unsigned char* lds, const float* slots) const {
        LAS float* S = (LAS float*)(lds + 4096);
        if (threadIdx.x < 256) { const f32x4* sp = (const f32x4*)(slots + (size_t)(u.pm * 256 + threadIdx.x) * 8); const f32x4 a = sp[0], b = sp[1];
            const float t = ((a.x + a.y) + (a.z + a.w)) + ((b.x + b.y) + (b.z + b.w)); S[threadIdx.x] = 1.0f / sqrtf(t * (1.0f / D) + RMS_EPS); }
        LDS_WAIT(); __syncthreads();
    }
    __device__ __forceinline__ void publish(const pg8::Unit& u, LAS unsigned char* lds, float* slots) const {
        const LAS float* P = (const LAS float*)lds;
        unsigned* cnt = (unsigned*)(ws + WS_BAR + 16384) + (size_t)(idx * 32 + u.pm) * 64;
        if (threadIdx.x < 256) { const f32x4 p = *(const LAS f32x4*)(P + threadIdx.x * 4);
            __hip_atomic_store((unsigned*)(slots + (size_t)(u.pm * 256 + threadIdx.x) * 8 + u.pn), __builtin_bit_cast(unsigned, (p.x + p.y) + (p.z + p.w)), __ATOMIC_RELAXED, __HIP_MEMORY_SCOPE_AGENT);
            asm volatile("s_waitcnt vmcnt(0)" ::: "memory");
            if ((threadIdx.x & 63) == 0) (void)__hip_atomic_fetch_add(cnt, 1u, __ATOMIC_RELAXED, __HIP_MEMORY_SCOPE_AGENT); }
    }
    __device__ __forceinline__ void wait_read(const pg8::Unit& u, LAS unsigned char* lds, const float* slots) const {
        unsigned* cnt = (unsigned*)(ws + WS_BAR + 16384) + (size_t)(idx * 32 + u.pm) * 64;
        if (threadIdx.x < 64) { unsigned sp = 0;
            while ((unsigned)__builtin_amdgcn_readfirstlane(__hip_atomic_load(cnt, __ATOMIC_RELAXED, __HIP_MEMORY_SCOPE_AGENT)) < 32u) { __builtin_amdgcn_s_sleep(2); if (++sp > (1u << 22)) break; }
            __builtin_amdgcn_fence(__ATOMIC_ACQUIRE, "agent");
            asm volatile("s_waitcnt vmcnt(0)" ::: "memory"); }
        __syncthreads();
        LAS float* S = (LAS float*)(lds + 4096);
        if (threadIdx.x < 256) { const unsigned* sp = (const unsigned*)(slots + (size_t)(u.pm * 256 + threadIdx.x) * 8); float t = 0.f;
#pragma unroll
            for (int j = 0; j < 8; ++j) t += __builtin_bit_cast(float, __hip_atomic_load(sp + j, __ATOMIC_RELAXED, __HIP_MEMORY_SCOPE_AGENT));
            S[threadIdx.x] = 1.0f / sqrtf(t * (1.0f / D) + RMS_EPS); }
        LDS_WAIT(); __syncthreads();
    }
    __device__ __forceinline__ void fused(f32x4 (&acc)[2][2][4][2], const pg8::Unit& u, int wr, int wc, int fr, int fq, LAS unsigned char* lds) const {
        const LAS float* S = (const LAS float*)(lds + 4096);
        float* sl1 = (float*)(ws + WS_SLOTS + (size_t)(2 * idx) * SZ_SLOT); float* sl2 = sl1 + SZ_SLOT / 4;
        const float* gpost = norm_gains + goff; bf16_t* XN = (bf16_t*)(ws + WS_XN);
        rowstat(acc, u, wr, wc, fr, fq, lds, nullptr);
        publish(u, lds, sl1);
        const int col0 = u.pn * 256 + wc * 32 + 8 * fq;
        u32x4 xw[2][4][2];
#pragma unroll
        for (int ai = 0; ai < 2; ++ai)
#pragma unroll
            for (int m = 0; m < 4; ++m)
#pragma unroll
                for (int bj = 0; bj < 2; ++bj) xw[ai][m][bj] = *(const u32x4*)(XN + (size_t)(u.pm * 256 + ai * 128 + wr * 64 + m * 16 + fr) * D + col0 + bj * 128);
        f32x4 gv[2][2];
#pragma unroll
        for (int bj = 0; bj < 2; ++bj)
#pragma unroll
            for (int n = 0; n < 2; ++n) gv[bj][n] = *(const f32x4*)(gpost + col0 + bj * 128 + n * 4) * coef;
        wait_read(u, lds, sl1);
#pragma unroll
        for (int ai = 0; ai < 2; ++ai)
#pragma unroll
            for (int m = 0; m < 4; ++m) { const int r = ai * 128 + wr * 64 + m * 16 + fr; const float rs = S[r]; const size_t off = (size_t)(u.pm * 256 + r) * D + col0;
#pragma unroll
                for (int bj = 0; bj < 2; ++bj) { const u32x4 w = xw[ai][m][bj];
                    const f32x4 xv0 = (f32x4){__builtin_bit_cast(float, w.x << 16), __builtin_bit_cast(float, w.x & 0xffff0000u), __builtin_bit_cast(float, w.y << 16), __builtin_bit_cast(float, w.y & 0xffff0000u)};
                    const f32x4 xv1 = (f32x4){__builtin_bit_cast(float, w.z << 16), __builtin_bit_cast(float, w.z & 0xffff0000u), __builtin_bit_cast(float, w.w << 16), __builtin_bit_cast(float, w.w & 0xffff0000u)};
                    const f32x4 xn0 = xv0 + (acc[ai][bj][m][0] * rs) * gv[bj][0], xn1 = xv1 + (acc[ai][bj][m][1] * rs) * gv[bj][1];
                    if (last) { *(f32x4*)(xout + off + bj * 128) = xn0; *(f32x4*)(xout + off + bj * 128 + 4) = xn1; }
                    acc[ai][bj][m][0] = xn0; acc[ai][bj][m][1] = xn1; } }
        if (last) return;
#pragma unroll
        for (int ai = 0; ai < 2; ++ai)
#pragma unroll
            for (int m = 0; m < 4; ++m) { const int r = ai * 128 + wr * 64 + m * 16 + fr; bf16_t* xo = XN + (size_t)(u.pm * 256 + r) * D + col0;
#pragma unroll
                for (int bj = 0; bj < 2; ++bj) { const f32x4 v0 = acc[ai][bj][m][0], v1 = acc[ai][bj][m][1];
                    u32x4 w; w.x = pg8::cvt_pk_bf16(v0.x, v0.y); w.y = pg8::cvt_pk_bf16(v0.z, v0.w); w.z = pg8::cvt_pk_bf16(v1.x, v1.y); w.w = pg8::cvt_pk_bf16(v1.z, v1.w);
                    *(u32x4*)(xo + bj * 128) = w; } }
        rowstat(acc, u, wr, wc, fr, fq, lds, sl2);
    }
};

struct Frame {
    LAS unsigned char* lds;
    int tid, lane, wave, vcu, G;
};

__device__ __forceinline__ void p0_transpose_item(const float* W, int K, int N, bf16_t* WT, const float* gain, const float* cscale, int mode, int row_off, LAS unsigned char* scr, int item, int lane) {
    const int nblk = N / 64, kb = item / nblk, nb = item % nblk, k0 = 64 * kb, n0 = 64 * nb;
    const int lq = lane >> 4, ln = lane & 15;
    const float* src = W + (size_t)(k0 + 4 * lq) * N + n0 + 4 * ln;
    f32x4 v[16];
#pragma unroll
    for (int j = 0; j < 4; ++j)
#pragma unroll
        for (int r = 0; r < 4; ++r) v[4 * j + r] = __builtin_nontemporal_load((const f32x4*)(src + (size_t)(16 * j + r) * N));
    const f32x4 cs = cscale ? *(const f32x4*)(cscale + n0 + 4 * ln) : (f32x4){1.f, 1.f, 1.f, 1.f};
#pragma unroll
    for (int j = 0; j < 4; ++j) {
        const f32x4 g4 = gain ? *(const f32x4*)(gain + k0 + 16 * j + 4 * lq) : (f32x4){1.f, 1.f, 1.f, 1.f};
        const f32x4 r0 = v[4 * j + 0] * cs * g4.x, r1 = v[4 * j + 1] * cs * g4.y, r2 = v[4 * j + 2] * cs * g4.z, r3 = v[4 * j + 3] * cs * g4.w;
#pragma unroll
        for (int i = 0; i < 4; ++i) { u32x2 w; w.x = pg8::cvt_pk_bf16(r0[i], r1[i]); w.y = pg8::cvt_pk_bf16(r2[i], r3[i]);
            *(LAS u32x2*)(scr + (4 * ln + i) * 144 + (16 * j + 4 * lq) * 2) = w; }
    }
    LDS_WAIT(); asm volatile("" ::: "memory");
    const int rbase = (mode == 0) ? (row_off + n0) : ((n0 >> 7) * 256 + (n0 & 127) + (mode == 2 ? 128 : 0));
    const int c = lane & 7;
#pragma unroll
    for (int q = 0; q < 8; ++q) { const int n = (lane >> 3) + 8 * q;
        const u32x4 o = *(const LAS u32x4*)(scr + n * 144 + c * 16);
        *(u32x4*)(WT + (size_t)(rbase + n) * K + k0 + 8 * c) = o; }
    LDS_WAIT(); asm volatile("" ::: "memory");
}

__device__ __forceinline__ int t5_bucket(int rel) {
    const int n = rel < 0 ? -rel : rel;
    const int v = n < 8 ? n : n < 12 ? 8 : n < 16 ? 9 : n < 23 ? 10 : n < 32 ? 11 : n < 46 ? 12 : n < 64 ? 13 : n < 91 ? 14 : 15;
    return (rel > 0 ? 16 : 0) + v;
}

struct Args {
    const float *x, *norm_gains, *wg, *wu, *wd, *pool_w, *pool_scale, *kv_norm, *w_k, *w_v, *rel_bias, *w_q, *w_o, *lambdas, *subln;
    float* out; unsigned char* ws; int ph_lo, ph_hi;
};

__device__ __forceinline__ const float* gains(const Args& a, int l, int sub, int pp) { return a.norm_gains + (size_t)((l * 3 + sub) * 2 + pp) * D; }

__device__ __forceinline__ void store_xraw(const f32x4 (&v)[8], bf16_t* orow, float* slot8, int lane) {
    float s = 0.f;
#pragma unroll
    for (int j = 0; j < 8; ++j) s += (v[j].x * v[j].x + v[j].y * v[j].y) + (v[j].z * v[j].z + v[j].w * v[j].w);
    s = wave_sum(s);
    u32x2* o8 = (u32x2*)orow + lane;
#pragma unroll
    for (int j = 0; j < 8; ++j) { u32x2 w; w.x = pg8::cvt_pk_bf16(v[j].x, v[j].y); w.y = pg8::cvt_pk_bf16(v[j].z, v[j].w); o8[64 * j] = w; }
    if (lane == 0) { *(f32x4*)slot8 = (f32x4){s, 0.f, 0.f, 0.f}; *(f32x4*)(slot8 + 4) = (f32x4){0.f, 0.f, 0.f, 0.f}; }
}

__device__ __forceinline__ void p0_prologue(Frame& F, const Args& a) {
    LAS unsigned char* scr = F.lds + F.wave * 16384;
    const int gw = F.vcu * NWAVES + F.wave, NGW = F.G * NWAVES;
    unsigned char* ws = a.ws;
    constexpr int I_FFN = (D / 64) * (DFF / 64);
    constexpr int I_SQ = (D / 64) * (D / 64);
    constexpr int I_PG = (512 / 64) * (512 / 64);
    constexpr int NITEMS = 8 * I_FFN;
    {
#define P0_SRC(it_) (((((it_) / I_FFN) & 1) == 0 ? a.wg : a.wu) + (size_t)(((it_) / I_FFN) >> 1) * D * DFF)
#define P0_LOAD(v, it_) do { const int item = (it_) % I_FFN, kb = item % (D / 64), nb = item / (D / 64); const float* src = P0_SRC(it_) + (size_t)(64 * kb + 4 * (F.lane >> 4)) * DFF + 64 * nb + 4 * (F.lane & 15); \
        _Pragma("unroll") for (int j = 0; j < 4; ++j) _Pragma("unroll") for (int r = 0; r < 4; ++r) v[4 * j + r] = __builtin_nontemporal_load((const f32x4*)(src + (size_t)(16 * j + r) * DFF)); } while (0)
#define P0_FINISH(v, it_) do { const int mat = (it_) / I_FFN, lf = mat >> 1, kind = mat & 1, item = (it_) % I_FFN, kb = item % (D / 64), nb = item / (D / 64), k0 = 64 * kb, n0 = 64 * nb; \
        const int lq = F.lane >> 4, ln = F.lane & 15; const float* gain = gains(a, lf >> 1, 2 * (lf & 1), 0); bf16_t* WT = (bf16_t*)(ws + WS_WGU + lf * SZ_WGU); \
        _Pragma("unroll") for (int j = 0; j < 4; ++j) { const f32x4 g4 = *(const f32x4*)(gain + k0 + 16 * j + 4 * lq); \
            const f32x4 r0 = v[4 * j + 0] * g4.x, r1 = v[4 * j + 1] * g4.y, r2 = v[4 * j + 2] * g4.z, r3 = v[4 * j + 3] * g4.w; \
            _Pragma("unroll") for (int i = 0; i < 4; ++i) { u32x2 w; w.x = pg8::cvt_pk_bf16(r0[i], r1[i]); w.y = pg8::cvt_pk_bf16(r2[i], r3[i]); *(LAS u32x2*)(scr + (4 * ln + i) * 144 + (16 * j + 4 * lq) * 2) = w; } } \
        LDS_WAIT(); asm volatile("" ::: "memory"); \
        const int rbase = (n0 >> 7) * 256 + (n0 & 127) + (kind ? 128 : 0), cc = F.lane & 7; \
        _Pragma("unroll") for (int q = 0; q < 8; ++q) { const int n = (F.lane >> 3) + 8 * q; const u32x4 o = *(const LAS u32x4*)(scr + n * 144 + cc * 16); *(u32x4*)(WT + (size_t)(rbase + n) * D + k0 + 8 * cc) = o; } \
        LDS_WAIT(); asm volatile("" ::: "memory"); } while (0)
        f32x4 vA[16], vB[16]; int it = gw;
        if (it < NITEMS) P0_LOAD(vA, it);
        while (it < NITEMS) {
            int nx = it + NGW;
            if (nx < NITEMS) P0_LOAD(vB, nx);
            P0_FINISH(vA, it);
            it = nx; if (it >= NITEMS) break;
            nx = it + NGW;
            if (nx < NITEMS) P0_LOAD(vA, nx);
            P0_FINISH(vB, it);
            it = nx;
        }
#undef P0_SRC
#undef P0_LOAD
#undef P0_FINISH
    }
    for (int m = gw; m < M; m += NGW) {
        const f32x4* xr = (const f32x4*)(a.x + (size_t)m * D) + F.lane; f32x4 v[8];
#pragma unroll
        for (int j = 0; j < 8; ++j) v[j] = __builtin_nontemporal_load(xr + 64 * j);
        store_xraw(v, (bf16_t*)(ws + WS_XN) + (size_t)m * D, (float*)(ws + WS_SLOTS + 12 * SZ_SLOT) + (size_t)m * 8, F.lane);
    }
    float* lut = (float*)(ws + WS_LUT);
    for (int i = blockIdx.x * 512 + F.tid; i < 16 * 256; i += F.G * 512) { const int mp = i >> 8, rel = (i & 255) - 192;
        lut[i] = (a.rel_bias[t5_bucket(rel) * 16 + mp] - a.rel_bias[15 * 16 + mp]) * LOG2E; }
    if (blockIdx.x == 0 && F.wave == 0) { const float* L = a.lambdas; const int lane = F.lane;
        const float s1 = wave_sum(L[lane] * L[128 + lane] + L[64 + lane] * L[192 + lane]);
        const float s2 = wave_sum(L[256 + lane] * L[384 + lane] + L[320 + lane] * L[448 + lane]);
        if (lane == 0) lut[4096] = expf(s1) - expf(s2) + LAMBDA_INIT; }
}

__device__ __forceinline__ void convert_wd_idle(Frame& F, const Args& a, int lf, int extra) {
    const int half = F.G >> 1;
    if ((int)blockIdx.x < half) return;
    constexpr int I_FFN = (D / 64) * (DFF / 64), I_SQ = (D / 64) * (D / 64), I_PG = (512 / 64) * (512 / 64);
    LAS unsigned char* scr = F.lds + F.wave * 16384;
    const int w0 = ((int)blockIdx.x - half) * NWAVES + F.wave, nw = (F.G - half) * NWAVES;
    for (int it = w0; it < I_FFN; it += nw)
        p0_transpose_item(a.wd + (size_t)lf * DFF * D, DFF, D, (bf16_t*)(a.ws + WS_WD + lf * SZ_WD), nullptr, nullptr, 0, 0, scr, it, F.lane);
#pragma unroll
    for (int w = 0; w < 4; ++w) if (extra & (2 << w)) {
        const float* W = w == 0 ? a.w_k : w == 1 ? a.w_v : w == 2 ? a.w_q : a.w_o;
        const float* gn = w < 2 ? a.kv_norm : w == 2 ? gains(a, 1, 1, 0) : nullptr;
        for (int it = w0; it < I_SQ; it += nw) p0_transpose_item(W, D, D, (bf16_t*)(a.ws + WS_WK + w * SZ_SQ), gn, nullptr, 0, 0, scr, it, F.lane); }
    if (extra & 1) for (int it = w0; it < 4 * I_PG; it += nw) { const int gi = it / I_PG;
        p0_transpose_item(a.pool_w + (size_t)gi * 512 * 512, 512, 512, (bf16_t*)(a.ws + WS_POOL), gains(a, 0, 1, 0) + gi * 512, a.pool_scale + gi * 512, 0, gi * 512, scr, it % I_PG, F.lane); }
}

__device__ __forceinline__ void pool_phase(Frame& F, const bf16_t* XN, const float* rsl, bf16_t* DP) {
    const int NIT = (M / 16) * 256;
    LAS float* T = (LAS float*)F.lds;
    for (int base = blockIdx.x * 512; base < NIT; base += F.G * 512) {
        const int r0 = (base >> 8) * 16 - 16;
        if (F.tid < 48) { const int row = r0 + F.tid; float v = 0.f;
            if (row >= 0) { const f32x4* sp = (const f32x4*)(rsl + (size_t)row * 8); const f32x4 a = sp[0], b = sp[1];
                const float t = ((a.x + a.y) + (a.z + a.w)) + ((b.x + b.y) + (b.z + b.w)); v = 1.0f / sqrtf(t * (1.0f / D) + RMS_EPS); }
            T[F.tid] = v; }
        LDS_WAIT(); __syncthreads();
        const int it = base + F.tid;
        const int o = it & 255, s = it >> 8, m0 = s * 16, t0 = m0 & (SEQ - 1), gi = o >> 6, win = 2 << gi;
        const bf16_t* bp = XN + (size_t)m0 * D + o * 8;
        const LAS float* Tm = T + (m0 - r0);
        float sum[8];
#pragma unroll
        for (int e = 0; e < 8; ++e) sum[e] = 0.f;
#define POOL_ACC(op, v, sc) do { sum[0] op __builtin_bit_cast(float, (v).x << 16) * (sc); sum[1] op __builtin_bit_cast(float, (v).x & 0xffff0000u) * (sc); sum[2] op __builtin_bit_cast(float, (v).y << 16) * (sc); sum[3] op __builtin_bit_cast(float, (v).y & 0xffff0000u) * (sc); \
        sum[4] op __builtin_bit_cast(float, (v).z << 16) * (sc); sum[5] op __builtin_bit_cast(float, (v).z & 0xffff0000u) * (sc); sum[6] op __builtin_bit_cast(float, (v).w << 16) * (sc); sum[7] op __builtin_bit_cast(float, (v).w & 0xffff0000u) * (sc); } while (0)
        for (int i = 1; i < win; ++i) if (t0 - i >= 0) { const u32x4 v = *(const u32x4*)(bp - (ptrdiff_t)i * D); const float sc = Tm[-i]; POOL_ACC(+=, v, sc); }
        for (int t = 0; t < 16; ++t) {
            const u32x4 v = *(const u32x4*)(bp + (size_t)t * D); const float sc = Tm[t];
            float c[8] = { __builtin_bit_cast(float, v.x << 16) * sc, __builtin_bit_cast(float, v.x & 0xffff0000u) * sc, __builtin_bit_cast(float, v.y << 16) * sc, __builtin_bit_cast(float, v.y & 0xffff0000u) * sc,
                           __builtin_bit_cast(float, v.z << 16) * sc, __builtin_bit_cast(float, v.z & 0xffff0000u) * sc, __builtin_bit_cast(float, v.w << 16) * sc, __builtin_bit_cast(float, v.w & 0xffff0000u) * sc };
#pragma unroll
            for (int e = 0; e < 8; ++e) sum[e] += c[e];
            const int tt = t0 + t;
            const float inv = 1.0f / (float)((tt + 1 < win) ? tt + 1 : win);
            u32x4 ov; ov.x = pg8::cvt_pk_bf16(sum[0] * inv - c[0], sum[1] * inv - c[1]); ov.y = pg8::cvt_pk_bf16(sum[2] * inv - c[2], sum[3] * inv - c[3]);
            ov.z = pg8::cvt_pk_bf16(sum[4] * inv - c[4], sum[5] * inv - c[5]); ov.w = pg8::cvt_pk_bf16(sum[6] * inv - c[6], sum[7] * inv - c[7]);
            if (tt + 1 - win >= 0) { const u32x4 w = *(const u32x4*)(bp + (ptrdiff_t)(t + 1 - win) * D); const float sw = Tm[t + 1 - win]; POOL_ACC(-=, w, sw); }
            *(u32x4*)(DP + (size_t)(m0 + t) * D + o * 8) = ov;
        }
#undef POOL_ACC
        __syncthreads();
    }
}

template <int MODE>
__device__ __forceinline__ void attn_phase(Frame& F, const bf16_t* Q, const bf16_t* Kb, const bf16_t* VT, bf16_t* O, const float* lutg, const float* subln) {
    LAS unsigned char* lds = F.lds;
    const int lane = F.lane, wid = F.wave, i16 = lane & 15, a = lane >> 4, c = wid >> 2, qg = wid & 3;
    LAS float* lut = (LAS float*)(lds + LUT_OFF);
    unsigned koff0, voff0;
    { const int rk = 2 * (wid & 1) + 8 * (wid >> 1) + (lane >> 5); const int chk = (lane & 31) ^ ((rk & 3) | (((rk >> 3) & 3) << 2)); koff0 = (unsigned)(rk * D + chk * 8) * 2u;
      const int rv = 8 * wid + (lane >> 3); const int chv = (lane & 7) ^ ((rv >> 1) & 7); voff0 = (unsigned)(rv * M + chv * 8) * 2u; }
#define ATT_STAGE_B(kb_, vb_, t, buf) do { const char* _kb = (kb_) + (size_t)(t) * (64 * D * 2); const char* _vb = (vb_) + (size_t)(t) * 128; \
        _Pragma("unroll") for (int _i = 0; _i < 4; ++_i) \
            __builtin_amdgcn_global_load_lds((const unsigned*)(_kb + (size_t)((4 * (_i & 1) + 32 * (_i >> 1)) * D * 2) + koff0), (LAS unsigned*)(lds + (buf) * 32768 + ((_i & 1) * 2 + (_i >> 1) * 16 + (wid & 1) + (wid >> 1) * 4) * 1024), 16, 0, 0); \
        _Pragma("unroll") for (int _i = 0; _i < 4; ++_i) \
            __builtin_amdgcn_global_load_lds((const unsigned*)(_vb + (size_t)(64 * _i) * M * 2 + voff0), (LAS unsigned*)(lds + 65536 + (buf) * 32768 + (wid + 8 * _i) * 1024), 16, 0, 0); } while (0)
#define ATT_STAGE(t, buf) ATT_STAGE_B(kbase, vbase, t, buf)
#define ATT_SETUP(u_, NT, QPOS0, MQ0, HH, KB, VB) do { const int P = (u_) & 255, rnd = (u_) >> 8, bh = P >> 3, jj = P & 7, b_ = bh >> 3, h_ = bh & 7; \
        const int q64 = rnd == 0 ? 31 - jj : rnd == 1 ? jj : rnd == 2 ? 23 - jj : 8 + jj; \
        NT = q64 + 1; QPOS0 = q64 * 64 + qg * 16; MQ0 = b_ * SEQ + QPOS0; HH = h_; \
        KB = (const char*)(Kb + (size_t)(b_ * SEQ) * D + h_ * 256); VB = (const char*)(VT + (size_t)(h_ * 256) * M + b_ * SEQ); \
        lut[F.tid] = lutg[(2 * h_ + (F.tid >> 8)) * 256 + (F.tid & 255)]; \
        _Pragma("unroll") for (int ks = 0; ks < 4; ++ks) qf[ks] = *(const bf16x8*)(Q + (size_t)(MQ0 + i16) * D + h_ * 256 + c * 128 + ks * 32 + a * 8); \
        ATT_STAGE_B(KB, VB, 0, 0); } while (0)
    int u = F.vcu;
    if (u < 1024) {
      bf16x8 qf[4]; int nt, qpos0, mq0, h; const char* kbase; const char* vbase;
      ATT_SETUP(u, nt, qpos0, mq0, h, kbase, vbase);
      for (;;) {
        f32x4 o[16];
#pragma unroll
        for (int d = 0; d < 16; ++d) o[d] = (f32x4){0.f, 0.f, 0.f, 0.f};
        float mrow = -1e30f, lrow = 0.f;
        for (int t = 0; t < nt; ++t) {
            const int buf = t & 1;
            VM_WAIT(); LDS_WAIT(); __builtin_amdgcn_s_barrier(); asm volatile("" ::: "memory");
            if (t + 1 < nt && MODE != 1) ATT_STAGE(t + 1, buf ^ 1);
            if (MODE == 2) continue;
            const LAS unsigned char* kb = lds + buf * 32768; const LAS unsigned char* vb = lds + 65536 + buf * 32768;
            const bool nearb = (t * 64 + 63 - qpos0) > -91;
            bf16x8 fr[16];
            f32x4 st[4];
#pragma unroll
            for (int kg = 0; kg < 4; ++kg) {
                const int row = 32 * (kg >> 1) + 8 * (i16 >> 2) + 4 * (kg & 1) + (i16 & 3);
#pragma unroll
                for (int ks = 0; ks < 4; ++ks) { const int ch = (c * 16 + ks * 4 + a) ^ i16; fr[kg * 4 + ks] = *(const LAS bf16x8*)(kb + row * 512 + ch * 16); } }
            __builtin_amdgcn_sched_barrier(0);
#pragma unroll
            for (int kg = 0; kg < 4; ++kg) { st[kg] = (f32x4){0.f, 0.f, 0.f, 0.f};
#pragma unroll
                for (int ks = 0; ks < 4; ++ks) st[kg] = __builtin_amdgcn_mfma_f32_16x16x32_bf16(fr[kg * 4 + ks], qf[ks], st[kg], 0, 0, 0); }
            __builtin_amdgcn_sched_barrier(0);
#define ATT_VLOAD(b, base) do { _Pragma("unroll") for (int _d = 0; _d < 4; ++_d) _Pragma("unroll") for (int _p = 0; _p < 2; ++_p) { const int ch = (4 * _p + a) ^ ((i16 >> 1) & 7); \
                fr[(base) + _d * 2 + _p] = *(const LAS bf16x8*)(vb + (((b) * 4 + _d) * 16 + i16) * 128 + ch * 16); } } while (0)
            ATT_VLOAD(0, 0);
            __builtin_amdgcn_sched_barrier(0);
            if (nearb) {
#pragma unroll
                for (int kg = 0; kg < 4; ++kg)
#pragma unroll
                    for (int j = 0; j < 4; ++j) { const int keyloc = 32 * (kg >> 1) + 8 * a + 4 * (kg & 1) + j; int idx = t * 64 + keyloc - (qpos0 + i16) + 192; idx = idx < 0 ? 0 : idx;
                        st[kg][j] += lut[c * 256 + idx]; }
            }
#define MAX3(a_, b_, c_) fmaxf(fmaxf((a_), (b_)), (c_))
            float mx = MAX3(st[0][0], st[0][1], st[0][2]); mx = MAX3(mx, st[0][3], st[1][0]); mx = MAX3(mx, st[1][1], st[1][2]); mx = MAX3(mx, st[1][3], st[2][0]);
            mx = MAX3(mx, st[2][1], st[2][2]); mx = MAX3(mx, st[2][3], st[3][0]); mx = MAX3(mx, st[3][1], st[3][2]); mx = fmaxf(mx, st[3][3]);
#undef MAX3
            float mnew = mrow, alpha = 1.0f;
            if (__builtin_amdgcn_ballot_w64(mx > mrow + 8.0f) != 0ull) {
                mx = fmaxf(mx, __shfl_xor(mx, 16)); mx = fmaxf(mx, __shfl_xor(mx, 32));
                mnew = fmaxf(mrow, mx); alpha = __builtin_amdgcn_exp2f(mrow - mnew); mrow = mnew; }
            float psum = 0.f;
#pragma unroll
            for (int kg = 0; kg < 4; ++kg)
#pragma unroll
                for (int j = 0; j < 4; ++j) { const float p = __builtin_amdgcn_exp2f(st[kg][j] - mnew); psum += p; st[kg][j] = p; }
            lrow = lrow * alpha + psum;
            if (__builtin_amdgcn_ballot_w64(alpha != 1.0f) != 0ull) {
#pragma unroll
                for (int d = 0; d < 16; ++d) o[d] = o[d] * alpha;
            }
            bf16x8 pf[2];
#pragma unroll
            for (int p = 0; p < 2; ++p) { u32x4 w; w.x = pg8::cvt_pk_bf16(st[2 * p][0], st[2 * p][1]); w.y = pg8::cvt_pk_bf16(st[2 * p][2], st[2 * p][3]);
                w.z = pg8::cvt_pk_bf16(st[2 * p + 1][0], st[2 * p + 1][1]); w.w = pg8::cvt_pk_bf16(st[2 * p + 1][2], st[2 * p + 1][3]); pf[p] = __builtin_bit_cast(bf16x8, w); }
            __builtin_amdgcn_sched_barrier(0);
#pragma unroll
            for (int b = 0; b < 4; ++b) {
                if (b < 3) { if (b == 0) ATT_VLOAD(1, 8); else if (b == 1) ATT_VLOAD(2, 0); else ATT_VLOAD(3, 8); }
                __builtin_amdgcn_sched_barrier(0);
#pragma unroll
                for (int d = 0; d < 4; ++d)
#pragma unroll
                    for (int p = 0; p < 2; ++p) o[b * 4 + d] = __builtin_amdgcn_mfma_f32_16x16x32_bf16(fr[(b & 1) * 8 + d * 2 + p], pf[p], o[b * 4 + d], 0, 0, 0);
                __builtin_amdgcn_sched_barrier(0);
            }
#undef ATT_VLOAD
        }
        float lt = lrow; lt += __shfl_xor(lt, 16); lt += __shfl_xor(lt, 32);
        LDS_WAIT(); __builtin_amdgcn_s_barrier(); asm volatile("" ::: "memory");
        const int mq0_c = mq0, h_c = h; const int un = u + F.G; const bool has_next = un < 1024;
        if (has_next) { ATT_SETUP(un, nt, qpos0, mq0, h, kbase, vbase); }
        LAS f32x4* xch = (LAS f32x4*)(lds + (qg < 2 ? 32768 + qg * 16384 : 98304 + (qg - 2) * 16384)) + lane;
        if (c == 1) { const float k1 = lutg[4096] / lt;
#pragma unroll
            for (int d = 0; d < 16; ++d) xch[d * 64] = o[d] * k1; }
        LDS_WAIT(); __builtin_amdgcn_s_barrier(); asm volatile("" ::: "memory");
        if (c == 0) {
            const float inv0 = 1.0f / lt; float ss = 0.f;
#pragma unroll
            for (int d = 0; d < 16; ++d) { const f32x4 v = o[d] * inv0 - xch[d * 64]; o[d] = v; ss += (v.x * v.x + v.y * v.y) + (v.z * v.z + v.w * v.w); }
            ss += __shfl_xor(ss, 16); ss += __shfl_xor(ss, 32);
            const float r = (1.0f - LAMBDA_INIT) / sqrtf(ss * (1.0f / 256.0f) + SUBLN_EPS);
            bf16_t* orow = O + (size_t)(mq0_c + i16) * D + h_c * 256 + 4 * a;
#pragma unroll
            for (int d = 0; d < 16; ++d) { const f32x4 g4 = *(const f32x4*)(subln + d * 16 + 4 * a); const f32x4 v = o[d] * g4 * r;
                u32x2 w; w.x = pg8::cvt_pk_bf16(v.x, v.y); w.y = pg8::cvt_pk_bf16(v.z, v.w); *(u32x2*)(orow + d * 16) = w; }
        }
        if (!has_next) break;
        u = un;
      }
    }
#undef ATT_STAGE
#undef ATT_STAGE_B
#undef ATT_SETUP
    LDS_WAIT(); __builtin_amdgcn_s_barrier(); asm volatile("" ::: "memory");
}

constexpr int N_PHASES = 14;
__global__ void __launch_bounds__(NWAVES * 64, 2) mk_fwd(Args args) {
    extern __shared__ __attribute__((aligned(16))) unsigned char lds_raw[];
    Frame F;
    F.lds = (LAS unsigned char*)lds_raw;
    F.tid = threadIdx.x; F.lane = F.tid & 63; F.wave = __builtin_amdgcn_readfirstlane(F.tid >> 6);
    F.G = gridDim.x; { const int bx = blockIdx.x; F.vcu = (F.G % 8 == 0) ? (bx % 8) * (F.G / 8) + bx / 8 : bx; }
    unsigned char* ws = args.ws;
    const int lo = args.ph_lo, hi = args.ph_hi;
    bf16_t* XN = (bf16_t*)(ws + WS_XN); bf16_t* ACT = (bf16_t*)(ws + WS_ACT); float* Y = (float*)(ws + WS_Y);
#define IN(k) (lo <= (k) && (k) < hi)
    volatile LAS unsigned* MISC = (volatile LAS unsigned*)(F.lds + MISC_OFF);
    if (F.tid < 4) MISC[F.tid] = 0u;
    __syncthreads();
    if (hi - lo > 1) (void)xcd_barrier_post((unsigned*)(ws + WS_BAR), MISC);
    if (lo < 0) cg::this_grid().sync();
#define SEAM(k) do { if (IN(k) && IN((k) + 1)) { grid_barrier(ws, F.lds); } } while (0)
#define GEMM_RUN(EPI, epi, Aptr, Bptr, N_, K_, lda_, ldb_, agrp_, M_) do { pg8::Gemm g{(Aptr), (Bptr), (M_), (N_), (K_), (lda_), (ldb_), (agrp_)}; pg8::StaticOrder S; S.init((M_), (N_), F.G, (int)blockIdx.x); \
        pg8::gemm_phase<EPI, pg8::StaticOrder, true>(F.lds, g, S, (epi)); } while (0)
#define RSL(k) ((const float*)(ws + WS_SLOTS + (size_t)(k) * SZ_SLOT))
#define FFN_G1(lf, rk) do { pg8::EpiSwiGLU e{ACT, DFF, RSL(rk)}; GEMM_RUN(pg8::EpiSwiGLU, e, XN, (const bf16_t*)(ws + WS_WGU + (lf) * SZ_WGU), 2 * DFF, D, D, D, 0, M); } while (0)
#define FFN_G2(lf) do { pg8::EpiF32 e{Y, D}; GEMM_RUN(pg8::EpiF32, e, ACT, (const bf16_t*)(ws + WS_WD + (lf) * SZ_WD), D, DFF, DFF, DFF, 0, M); } while (0)

#define PH(k, ...) do { if (IN(k)) { for (int _r = 0; _r <= (int)((DUP_MASK >> (k)) & 1u); ++_r) { if (_r) grid_barrier(ws, F.lds); __VA_ARGS__ } } SEAM(k); } while (0)
#define FUSED_TAIL(idx, xin_, l_, sub_, coef_, last_) EpiNormRes e{args.x, args.out, args.norm_gains, ws, (idx), (((l_) * 3 + (sub_)) * 2 + 1) * D, ((idx) == 0), (last_), (coef_)}
#define FFN_G2F(lf, idx, xin_, l_, sub_, last_) do { FUSED_TAIL(idx, xin_, l_, sub_, 0.5f, last_); GEMM_RUN(EpiNormRes, e, ACT, (const bf16_t*)(ws + WS_WD + (lf) * SZ_WD), D, DFF, DFF, DFF, 0, M); } while (0)
    PH(0, p0_prologue(F, args););
    PH(1, FFN_G1(0, 12); convert_wd_idle(F, args, 0, 1 | 2););
    PH(2, FFN_G2F(0, 0, args.x, 0, 0, 0););
    PH(3, pool_phase(F, XN, RSL(1), (bf16_t*)(ws + WS_DP)););
    PH(4, { FUSED_TAIL(1, args.out, 0, 1, 1.0f, 0); GEMM_RUN(EpiNormRes, e, (const bf16_t*)(ws + WS_DP), (const bf16_t*)(ws + WS_POOL), D, 512, D, 512, 1, M); });
    PH(5, FFN_G1(1, 3); convert_wd_idle(F, args, 1, 4););
    PH(6, FFN_G2F(1, 2, args.out, 0, 2, 0););
    PH(7, { pg8::EpiBf16<1> e{(bf16_t*)(ws + WS_K), D, 1.0f, RSL(5)}; GEMM_RUN(pg8::EpiBf16<1>, e, XN, (const bf16_t*)(ws + WS_WK), D, D, D, D, 0, M); }
          { pg8::EpiBf16<2> e{(bf16_t*)(ws + WS_VT), M, 1.0f, RSL(5)}; GEMM_RUN(pg8::EpiBf16<2>, e, (const bf16_t*)(ws + WS_WV), XN, M, D, D, D, 0, D); }
          FFN_G1(2, 5); convert_wd_idle(F, args, 2, 8 | 16););
    PH(8, FFN_G2F(2, 3, args.out, 1, 0, 0););
    PH(9, { pg8::EpiBf16<1> e{(bf16_t*)(ws + WS_Q), D, QSCALE, RSL(7)}; GEMM_RUN(pg8::EpiBf16<1>, e, XN, (const bf16_t*)(ws + WS_WQ), D, D, D, D, 0, M); });
    PH(10, attn_phase<0>(F, (const bf16_t*)(ws + WS_Q), (const bf16_t*)(ws + WS_K), (const bf16_t*)(ws + WS_VT), (bf16_t*)(ws + WS_O), (const float*)(ws + WS_LUT), args.subln););
    PH(11, { FUSED_TAIL(4, args.out, 1, 1, 1.0f, 0); GEMM_RUN(EpiNormRes, e, (const bf16_t*)(ws + WS_O), (const bf16_t*)(ws + WS_WO), D, D, D, D, 0, M); });
    PH(12, FFN_G1(3, 9); convert_wd_idle(F, args, 3, 0););
    PH(13, FFN_G2F(3, 5, args.out, 1, 2, 1););
}

extern "C" void kernel_launch(void* const* d_in, const int* in_sizes, int n_in, void* d_out, int out_size, void* d_ws, size_t ws_size, hipStream_t stream) {
    static int grid = 0;
    if (grid == 0) {
        if (n_in != 15 || in_sizes[0] != M * D || out_size != M * D || ws_size < WS_END) { fprintf(stderr, "kernel_launch: unexpected shapes (n_in %d in0 %d out %d ws %zu need %zu)\n", n_in, n_in > 0 ? in_sizes[0] : -1, out_size, ws_size, (size_t)WS_END); grid = -1; return; }
        int dev = 0, cus = 0, per_cu = 0;
        hipGetDevice(&dev); hipDeviceGetAttribute(&cus, hipDeviceAttributeMultiprocessorCount, dev);
        if (hipFuncSetAttribute((const void*)mk_fwd, hipFuncAttributeMaxDynamicSharedMemorySize, LDS_BYTES) != hipSuccess) { fprintf(stderr, "kernel_launch: hipFuncSetAttribute failed\n"); grid = -1; return; }
        if (hipOccupancyMaxActiveBlocksPerMultiprocessor(&per_cu, (const void*)mk_fwd, NWAVES * 64, LDS_BYTES) != hipSuccess || per_cu < 1) { fprintf(stderr, "kernel_launch: occupancy query says %d\n", per_cu); per_cu = 1; }
        (void)hipGetLastError();
        grid = cus * per_cu;
        if (grid != 256) { fprintf(stderr, "kernel_launch: this kernel is built for a 256-workgroup resident grid (one per CU), got %d; nothing launched\n", grid); grid = -1; return; }
        fprintf(stderr, "kernel_launch: grid %d (cus %d x %d)\n", grid, cus, per_cu);
    }
    if (grid < 0) return;
    Args a{};
    a.x = (const float*)d_in[0]; a.norm_gains = (const float*)d_in[1]; a.wg = (const float*)d_in[2]; a.wu = (const float*)d_in[3]; a.wd = (const float*)d_in[4];
    a.pool_w = (const float*)d_in[5]; a.pool_scale = (const float*)d_in[6]; a.kv_norm = (const float*)d_in[7]; a.w_k = (const float*)d_in[8]; a.w_v = (const float*)d_in[9];
    a.rel_bias = (const float*)d_in[10]; a.w_q = (const float*)d_in[11]; a.w_o = (const float*)d_in[12]; a.lambdas = (const float*)d_in[13]; a.subln = (const float*)d_in[14];
    a.out = (float*)d_out; a.ws = (unsigned char*)d_ws;
    if (hipMemsetAsync((char*)d_ws + WS_BAR, 0, BAR_BYTES, stream) != hipSuccess) { fprintf(stderr, "kernel_launch: memset failed\n"); return; }
#if MK_MULTI
    for (int p = 0; p < N_PHASES; ++p) { a.ph_lo = p; a.ph_hi = p + 1; hipLaunchKernelGGL(mk_fwd, dim3(grid), dim3(NWAVES * 64), LDS_BYTES, stream, a); }
#else
    a.ph_lo = 0; a.ph_hi = N_PHASES;
    void* kargs[] = {&a};
    hipError_t e = hipLaunchCooperativeKernel((const void*)mk_fwd, dim3(grid), dim3(NWAVES * 64), kargs, LDS_BYTES, stream);
    if (e != hipSuccess) fprintf(stderr, "kernel_launch: cooperative launch failed: %s (grid %d)\n", hipGetErrorString(e), grid);
#endif
}
```

```cpp
#include <hip/hip_runtime.h>
#include <hip/hip_cooperative_groups.h>
#include <cstdio>
#include <cstdint>
namespace cg = cooperative_groups;

#ifndef MK_MULTI
#define MK_MULTI 0
#endif

#ifndef DUP_MASK
#define DUP_MASK 0u
#endif

#define LAS __attribute__((address_space(3)))
#define GAS __attribute__((address_space(1)))
typedef unsigned short bf16_t;
typedef short bf16x8 __attribute__((ext_vector_type(8)));
typedef float f32x4 __attribute__((ext_vector_type(4)));
typedef float f32x2 __attribute__((ext_vector_type(2)));
typedef unsigned u32x4 __attribute__((ext_vector_type(4)));
typedef unsigned u32x2 __attribute__((ext_vector_type(2)));

constexpr int D = 2048, BATCH = 4, SEQ = 2048, M = BATCH * SEQ, DFF = 5632, NH = 8;
constexpr float RMS_EPS = 1e-6f, SUBLN_EPS = 1e-5f;
constexpr float LAMBDA_INIT = 0.35550906759f;
constexpr float LOG2E = 1.44269504089f;
constexpr float QSCALE = 0.08838834764831845f * LOG2E;

constexpr size_t SZ_WGU = (size_t)2 * DFF * D * 2, SZ_WD = (size_t)D * DFF * 2, SZ_SQ = (size_t)D * D * 2, SZ_ACT = (size_t)M * DFF * 2, SZ_MD2 = (size_t)M * D * 2;
constexpr size_t WS_WGU = 0;
constexpr size_t WS_WD = WS_WGU + 4 * SZ_WGU;
constexpr size_t WS_POOL = WS_WD + 4 * SZ_WD;
constexpr size_t WS_WK = WS_POOL + (size_t)D * 512 * 2;
constexpr size_t WS_WV = WS_WK + SZ_SQ, WS_WQ = WS_WV + SZ_SQ, WS_WO = WS_WQ + SZ_SQ;
constexpr size_t WS_XN = WS_WO + SZ_SQ;
constexpr size_t WS_ACT = WS_XN + SZ_MD2;
constexpr size_t WS_DP = WS_ACT, WS_Q = WS_ACT, WS_O = WS_ACT + SZ_MD2;
constexpr size_t WS_Y = WS_ACT + SZ_ACT;
constexpr size_t WS_K = WS_Y + (size_t)M * D * 4;
constexpr size_t WS_VT = WS_K + SZ_MD2;
constexpr size_t WS_LUT = WS_VT + SZ_MD2;
constexpr size_t WS_BAR = WS_LUT + 16 * 256 * 4 + 256;
constexpr size_t BAR_BYTES = 65536;
constexpr size_t WS_SLOTS = WS_BAR + BAR_BYTES;
constexpr size_t SZ_SLOT = (size_t)M * 8 * 4;
constexpr size_t WS_END = WS_SLOTS + 13 * SZ_SLOT;

constexpr int RING_BYTES = 131072, LUT_OFF = RING_BYTES, RST_OFF = RING_BYTES  , MISC_OFF = RING_BYTES + 4096, LDS_BYTES = 147456;
constexpr int NWAVES = 8;

namespace pg8 {
constexpr int BM = 256, BK = 64, HALF = 128, HTB = HALF * BK * 2, NXCD = 8, WGM = 8;
__host__ __device__ __forceinline__ int lds_byte(int r, int c) { const int st = (r >> 4) * 2 + (c >> 5), rr = r & 15, cc = c & 31, ob = rr * 64 + cc * 2; return st * 1024 + (ob ^ (((ob >> 9) & 1) << 5)); }
__host__ __device__ __forceinline__ void stage_rc(int b, int& R, int& C) { const int st = b / 1024, sb = b % 1024, swz = sb ^ (((sb >> 9) & 1) << 5); R = (st >> 1) * 16 + swz / 64; C = (st & 1) * 32 + (swz % 64) / 2; }
__host__ __device__ __forceinline__ int perm32(int rho) { const int n = rho >> 4, i = rho & 15; return 8 * (i >> 2) + 4 * n + (i & 3); }

struct Unit { int pm, pn; };
struct Gemm { const bf16_t* A; const bf16_t* Bt; int M, N, K, lda, ldb, agrp; };

struct StaticOrder {
    int nM, nN, nwg, G, c;
    __host__ __device__ void init(int M_, int N_, int G_, int c_) { nM = M_ / BM; nN = N_ / BM; nwg = nM * nN; G = G_; c = c_; }
    __host__ __device__ bool next(int i, Unit& u) const {
        const long L = (long)i * G + c; if (L >= nwg) return false;
        int wgid = (int)L; { const int q = nwg / NXCD, r = nwg % NXCD, xcd = wgid % NXCD, off = wgid / NXCD; wgid = (xcd < r ? xcd * (q + 1) : r * (q + 1) + (xcd - r) * q) + off; }
        const int nig = WGM * nN, gid = wgid / nig, fm = gid * WGM, gsz = (nM - fm) < WGM ? (nM - fm) : WGM;
        u.pm = fm + ((wgid % nig) % gsz); u.pn = (wgid % nig) / gsz; return true;
    }
};

__device__ __forceinline__ unsigned cvt_pk_bf16(float lo, float hi) { unsigned r; asm volatile("v_cvt_pk_bf16_f32 %0, %1, %2" : "=v"(r) : "v"(lo), "v"(hi)); return r; }

struct EpiF32 {
    static constexpr bool PERM = false, AFTER_DRAIN = false; static constexpr int RS = 0;
    float* C; int ldc; const float* rsl;
    __device__ __forceinline__ void operator()(const f32x4 (&acc)[2][2][4][2], const Unit& u, int wr, int wc, int fr, int fq, const LAS float* T) const {
        const int row0 = u.pm * BM + wr * 64 + fr, col0 = u.pn * BM + wc * 32 + 4 * fq;
#pragma unroll
        for (int ai = 0; ai < 2; ++ai)
#pragma unroll
            for (int m = 0; m < 4; ++m) { float* rowp = C + (size_t)(row0 + ai * HALF + m * 16) * ldc + col0;
#pragma unroll
                for (int bj = 0; bj < 2; ++bj)
#pragma unroll
                    for (int n = 0; n < 2; ++n) *(f32x4*)(rowp + bj * HALF + n * 16) = acc[ai][bj][m][n]; }
    }
};
template <int RS_>
struct EpiBf16 {
    static constexpr bool PERM = true, AFTER_DRAIN = false; static constexpr int RS = RS_;
    bf16_t* O; int ldc; float scale; const float* rsl;
    __device__ __forceinline__ void operator()(const f32x4 (&acc)[2][2][4][2], const Unit& u, int wr, int wc, int fr, int fq, const LAS float* T) const {
        const int row0 = u.pm * BM + wr * 64 + fr, col0 = u.pn * BM + wc * 32 + 8 * fq;
        f32x4 cs[2][2];
#pragma unroll
        for (int bj = 0; bj < 2; ++bj)
#pragma unroll
            for (int n = 0; n < 2; ++n) cs[bj][n] = (RS_ == 2) ? *(const LAS f32x4*)(T + bj * HALF + wc * 32 + 8 * fq + 4 * n) * scale : (f32x4){scale, scale, scale, scale};
#pragma unroll
        for (int ai = 0; ai < 2; ++ai)
#pragma unroll
            for (int m = 0; m < 4; ++m) { bf16_t* rowp = O + (size_t)(row0 + ai * HALF + m * 16) * ldc + col0; const float rsr = (RS_ == 1) ? T[ai * HALF + wr * 64 + m * 16 + fr] : 1.0f;
#pragma unroll
                for (int bj = 0; bj < 2; ++bj) { const f32x4 v0 = acc[ai][bj][m][0] * cs[bj][0] * rsr, v1 = acc[ai][bj][m][1] * cs[bj][1] * rsr;
                    u32x4 w; w.x = cvt_pk_bf16(v0[0], v0[1]); w.y = cvt_pk_bf16(v0[2], v0[3]); w.z = cvt_pk_bf16(v1[0], v1[1]); w.w = cvt_pk_bf16(v1[2], v1[3]);
                    *(u32x4*)(rowp + bj * HALF) = w; } }
    }
};
__device__ __forceinline__ f32x2 silu_mul2(f32x2 g, f32x2 u) {
    const f32x2 t = g * (-LOG2E); f32x2 e; e.x = __builtin_amdgcn_exp2f(t.x); e.y = __builtin_amdgcn_exp2f(t.y);
    const f32x2 d = e + 1.0f; f32x2 r; r.x = __builtin_amdgcn_rcpf(d.x); r.y = __builtin_amdgcn_rcpf(d.y);
    return (g * u) * r;
}
struct EpiSwiGLU {
    static constexpr bool PERM = true, AFTER_DRAIN = false; static constexpr int RS = 1;
    bf16_t* O; int ldc; const float* rsl;
    __device__ __forceinline__ void operator()(const f32x4 (&acc)[2][2][4][2], const Unit& u, int wr, int wc, int fr, int fq, const LAS float* T) const {
        const int row0 = u.pm * BM + wr * 64 + fr, col0 = u.pn * HALF + wc * 32 + 8 * fq;
#pragma unroll
        for (int ai = 0; ai < 2; ++ai)
#pragma unroll
            for (int m = 0; m < 4; ++m) { bf16_t* rowp = O + (size_t)(row0 + ai * HALF + m * 16) * ldc + col0;
                const float rsr = T[ai * HALF + wr * 64 + m * 16 + fr];
                const f32x4 g0 = acc[ai][0][m][0] * rsr, g1 = acc[ai][0][m][1] * rsr, u0 = acc[ai][1][m][0] * rsr, u1 = acc[ai][1][m][1] * rsr;
                const f32x2 a0 = silu_mul2((f32x2){g0[0], g0[1]}, (f32x2){u0[0], u0[1]}), a1 = silu_mul2((f32x2){g0[2], g0[3]}, (f32x2){u0[2], u0[3]});
                const f32x2 a2 = silu_mul2((f32x2){g1[0], g1[1]}, (f32x2){u1[0], u1[1]}), a3 = silu_mul2((f32x2){g1[2], g1[3]}, (f32x2){u1[2], u1[3]});
                u32x4 w; w.x = cvt_pk_bf16(a0.x, a0.y); w.y = cvt_pk_bf16(a1.x, a1.y); w.z = cvt_pk_bf16(a2.x, a2.y); w.w = cvt_pk_bf16(a3.x, a3.y);
                *(u32x4*)rowp = w; }
    }
};

#ifndef PG8_SP2
#define PG8_SP2 true
#endif
__device__ __forceinline__ void build_rs_table(LAS unsigned char* lds, const float* rsl, int panel) {
    LAS float* T = (LAS float*)(lds + RST_OFF);
    if (threadIdx.x < 256) { const f32x4* sp = (const f32x4*)(rsl + (size_t)(panel * 256 + (int)threadIdx.x) * 8); const f32x4 a = sp[0], b = sp[1];
        const float t = ((a.x + a.y) + (a.z + a.w)) + ((b.x + b.y) + (b.z + b.w)); T[threadIdx.x] = 1.0f / sqrtf(t * (1.0f / D) + RMS_EPS); }
    asm volatile("s_waitcnt lgkmcnt(0)" ::: "memory"); __syncthreads();
}
template <class Epi, class Sched, bool ALIGN_EPI = true, bool SP2 = PG8_SP2>
__device__ __forceinline__ void gemm_phase(LAS unsigned char* lds, const Gemm g, const Sched& S, const Epi& E) {
    static_assert(Epi::RS == 0 || ALIGN_EPI, "the row-scale table rebuild needs the aligned epilogue");
    const int tid = threadIdx.x, wid = __builtin_amdgcn_readfirstlane(tid >> 6), lane = tid & 63, wr = wid >> 2, wc = wid & 3, fr = lane & 15, fq = lane >> 4;
    const int K = g.K, nt = K / BK;
    unsigned voffA[2], voffB[2];
#pragma unroll
    for (int i = 0; i < 2; ++i) { const int R = i * 64 + wid * 8 + (lane >> 3), C = (((lane & 7) ^ ((R >> 1) & 7)) * 8); const int Rb = Epi::PERM ? ((R & ~31) + perm32(R & 31)) : R;
        voffA[i] = (unsigned)(R * g.lda + C) * 2u; voffB[i] = (unsigned)(Rb * g.ldb + C) * 2u; }
    const size_t kstep = (size_t)(BK * 2);
    const size_t hstepA = (size_t)HALF * g.lda * 2, hstepB = (size_t)HALF * g.ldb * 2;
    const size_t tstepA = 2 * hstepA, tstepB = 2 * hstepB;
    const unsigned ldsw = (unsigned)wid * 1024u;
    const int sw = (fr >> 1) & 7;
    const int aoff0 = (wr * 64 + fr) * 128 + ((fq ^ sw) * 16), aoff1 = (wr * 64 + fr) * 128 + (((4 + fq) ^ sw) * 16);
    const int boff0 = (wc * 32 + fr) * 128 + ((fq ^ sw) * 16), boff1 = (wc * 32 + fr) * 128 + (((4 + fq) ^ sw) * 16);
#define PG8_SA(b, h) (((b) * 2 + (h)) * HTB)
#define PG8_SB(b, h) ((4 + (b) * 2 + (h)) * HTB)
#define PG8_STAGE(bufoff, gbase, voff) do { _Pragma("unroll") for (int _i = 0; _i < 2; ++_i) \
        __builtin_amdgcn_global_load_lds((const unsigned*)((const char*)(gbase) + (voff)[_i]), (LAS unsigned*)(lds + (bufoff) + ldsw + _i * 8192), 16, 0, 0); } while (0)
#define PG8_LDA(dst, b, h) do { _Pragma("unroll") for (int m = 0; m < 4; ++m) _Pragma("unroll") for (int k = 0; k < 2; ++k) dst[m][k] = *(const LAS bf16x8*)(lds + PG8_SA(b, h) + (k ? aoff1 : aoff0) + m * 2048); } while (0)
#define PG8_LDB(dst, b, h) do { _Pragma("unroll") for (int n = 0; n < 2; ++n) _Pragma("unroll") for (int k = 0; k < 2; ++k) dst[n][k] = *(const LAS bf16x8*)(lds + PG8_SB(b, h) + (k ? boff1 : boff0) + n * 2048); } while (0)
#define PG8_MMA(ai, bj, At, Bt) do { __builtin_amdgcn_s_setprio(1); _Pragma("unroll") for (int m = 0; m < 4; ++m) _Pragma("unroll") for (int n = 0; n < 2; ++n) _Pragma("unroll") for (int k = 0; k < 2; ++k) \
        acc[ai][bj][m][n] = __builtin_amdgcn_mfma_f32_16x16x32_bf16(Bt[n][k], At[m][k], acc[ai][bj][m][n], 0, 0, 0); __builtin_amdgcn_s_setprio(0); } while (0)
#define PG8_WAIT_V(n) asm volatile("s_waitcnt vmcnt(" #n ")" ::: "memory")
#define PG8_WAIT_L(n) asm volatile("s_waitcnt lgkmcnt(" #n ")" ::: "memory")
#define PG8_BAR __builtin_amdgcn_s_barrier()
#define PG8_SCHED __builtin_amdgcn_sched_barrier(0)
#define PG8_AOFF(u) ((size_t)(u).pm * tstepA + (g.agrp ? (size_t)((u).pn >> 1) * 1024 : (size_t)0))
    Unit cur, nxt; int ui = 0;
    if (!S.next(0, cur)) return;
    const LAS float* T = (const LAS float*)(lds + RST_OFF); int tpanel = -1;
    f32x4 acc[2][2][4][2];
#pragma unroll
    for (int a = 0; a < 2; ++a)
#pragma unroll
        for (int b = 0; b < 2; ++b)
#pragma unroll
            for (int m = 0; m < 4; ++m)
#pragma unroll
                for (int n = 0; n < 2; ++n) acc[a][b][m][n] = (f32x4){0.f, 0.f, 0.f, 0.f};
    bf16x8 At[4][2], B0[2][2], B1[2][2];
    const char* cA = (const char*)g.A + PG8_AOFF(cur); const char* cB = (const char*)g.Bt + (size_t)cur.pn * tstepB;
    if constexpr (SP2) {
    PG8_STAGE(PG8_SB(0, 0), cB, voffB); PG8_STAGE(PG8_SB(0, 1), cB + hstepB, voffB); PG8_STAGE(PG8_SA(0, 0), cA, voffA); PG8_STAGE(PG8_SA(0, 1), cA + hstepA, voffA);
    if constexpr (Epi::RS != 0) { tpanel = Epi::RS == 1 ? cur.pm : cur.pn; build_rs_table(lds, E.rsl, tpanel); }
    if (wr == 1) PG8_BAR;
    PG8_WAIT_V(2); PG8_BAR;
    PG8_STAGE(PG8_SB(1, 0), cB + kstep, voffB); PG8_STAGE(PG8_SA(1, 0), cA + kstep, voffA); PG8_STAGE(PG8_SB(1, 1), cB + hstepB + kstep, voffB);
    PG8_WAIT_V(6); PG8_BAR;
    } else {
    PG8_STAGE(PG8_SB(0, 0), cB, voffB); PG8_STAGE(PG8_SA(0, 0), cA, voffA); PG8_STAGE(PG8_SB(0, 1), cB + hstepB, voffB); PG8_STAGE(PG8_SA(0, 1), cA + hstepA, voffA);
    if (wr == 1) PG8_BAR;
    PG8_WAIT_V(4); PG8_BAR;
    PG8_STAGE(PG8_SB(1, 0), cB + kstep, voffB); PG8_STAGE(PG8_SA(1, 0), cA + kstep, voffA); PG8_STAGE(PG8_SB(1, 1), cB + hstepB + kstep, voffB);
    PG8_WAIT_V(6); PG8_BAR;
    }
    for (;;) {
        const bool has_next = S.next(ui + 1, nxt);
        const char* nA = has_next ? (const char*)g.A + PG8_AOFF(nxt) : cA; const char* nB = has_next ? (const char*)g.Bt + (size_t)nxt.pn * tstepB : cB;
        for (int t = 0; t < nt; t += 2) {
            const bool last = (t == nt - 2);
            const char* a1 = cA + (size_t)(t + 1) * kstep;
            const char* a2 = last ? nA : cA + (size_t)(t + 2) * kstep; const char* b2 = last ? nB : cB + (size_t)(t + 2) * kstep;
            const char* a3 = a2 + kstep; const char* b3 = b2 + kstep;
            if constexpr (SP2) {
            PG8_LDB(B0, 0, 0); PG8_LDB(B1, 0, 1); PG8_SCHED; PG8_LDA(At, 0, 0); PG8_STAGE(PG8_SA(1, 1), a1 + hstepA, voffA);
            PG8_WAIT_V(8); PG8_WAIT_L(0); PG8_BAR; PG8_MMA(0, 0, At, B0); PG8_MMA(0, 1, At, B1); PG8_BAR; PG8_SCHED;
            PG8_LDA(At, 0, 1); PG8_STAGE(PG8_SB(0, 0), b2, voffB); PG8_STAGE(PG8_SB(0, 1), b2 + hstepB, voffB); PG8_STAGE(PG8_SA(0, 0), a2, voffA);
            PG8_WAIT_V(8); PG8_WAIT_L(0); PG8_BAR; PG8_MMA(1, 0, At, B0); PG8_MMA(1, 1, At, B1); PG8_BAR; PG8_SCHED;
            PG8_LDB(B0, 1, 0); PG8_LDB(B1, 1, 1); PG8_SCHED; PG8_LDA(At, 1, 0); PG8_STAGE(PG8_SA(0, 1), a2 + hstepA, voffA);
            PG8_WAIT_V(8); PG8_WAIT_L(0); PG8_BAR; PG8_MMA(0, 0, At, B0); PG8_MMA(0, 1, At, B1); PG8_BAR; PG8_SCHED;
            PG8_LDA(At, 1, 1); PG8_STAGE(PG8_SB(1, 0), b3, voffB); PG8_STAGE(PG8_SB(1, 1), b3 + hstepB, voffB); PG8_STAGE(PG8_SA(1, 0), a3, voffA);
            PG8_WAIT_V(8); PG8_WAIT_L(0); PG8_BAR; PG8_MMA(1, 0, At, B0); PG8_MMA(1, 1, At, B1); PG8_BAR; PG8_SCHED;
            } else {
            PG8_LDB(B0, 0, 0); PG8_SCHED; PG8_LDA(At, 0, 0); PG8_STAGE(PG8_SA(1, 1), a1 + hstepA, voffA);
            PG8_WAIT_L(8); PG8_BAR; PG8_WAIT_L(0); PG8_MMA(0, 0, At, B0); PG8_BAR; PG8_SCHED;
            PG8_LDB(B1, 0, 1); PG8_STAGE(PG8_SB(0, 0), b2, voffB);
            PG8_BAR; PG8_WAIT_L(0); PG8_MMA(0, 1, At, B1); PG8_BAR;
            PG8_LDA(At, 0, 1); PG8_STAGE(PG8_SA(0, 0), a2, voffA);
            PG8_BAR; PG8_WAIT_L(0); PG8_MMA(1, 0, At, B0); PG8_BAR; PG8_SCHED;
            PG8_STAGE(PG8_SB(0, 1), b2 + hstepB, voffB);
            PG8_WAIT_V(6); PG8_BAR; PG8_MMA(1, 1, At, B1); PG8_BAR;
            PG8_LDB(B0, 1, 0); PG8_SCHED; PG8_LDA(At, 1, 0); PG8_STAGE(PG8_SA(0, 1), a2 + hstepA, voffA);
            PG8_WAIT_L(8); PG8_BAR; PG8_WAIT_L(0); PG8_MMA(0, 0, At, B0); PG8_BAR; PG8_SCHED;
            PG8_LDB(B1, 1, 1); PG8_STAGE(PG8_SB(1, 0), b3, voffB);
            PG8_BAR; PG8_WAIT_L(0); PG8_MMA(0, 1, At, B1); PG8_BAR;
            PG8_LDA(At, 1, 1); PG8_STAGE(PG8_SA(1, 0), a3, voffA);
            PG8_BAR; PG8_WAIT_L(0); PG8_MMA(1, 0, At, B0); PG8_BAR; PG8_SCHED;
            PG8_STAGE(PG8_SB(1, 1), b3 + hstepB, voffB);
            PG8_WAIT_V(6); PG8_BAR; PG8_MMA(1, 1, At, B1); PG8_BAR;
            }
        }
        if constexpr (ALIGN_EPI) { if (wr == 0) PG8_BAR; }
        if constexpr (Epi::RS != 0) { const int p = Epi::RS == 1 ? cur.pm : cur.pn;
            if (p != tpanel) { __syncthreads(); build_rs_table(lds, E.rsl, p); tpanel = p; } }
        if constexpr (!Epi::AFTER_DRAIN) E(acc, cur, wr, wc, fr, fq, T);
        if (!has_next) break;
#pragma unroll
        for (int a = 0; a < 2; ++a)
#pragma unroll
            for (int b = 0; b < 2; ++b)
#pragma unroll
                for (int m = 0; m < 4; ++m)
#pragma unroll
                    for (int n = 0; n < 2; ++n) acc[a][b][m][n] = (f32x4){0.f, 0.f, 0.f, 0.f};
        cur = nxt; cA = nA; cB = nB; ++ui;
        if constexpr (ALIGN_EPI) { if (wr == 1) PG8_BAR; }
    }
    PG8_WAIT_V(0);
    if constexpr (!ALIGN_EPI) { if (wr == 0) PG8_BAR; }
    PG8_BAR;
    if constexpr (Epi::AFTER_DRAIN) E.fused(acc, cur, wr, wc, fr, fq, lds);
#undef PG8_SA
#undef PG8_SB
#undef PG8_STAGE
#undef PG8_LDA
#undef PG8_LDB
#undef PG8_MMA
#undef PG8_AOFF
}
}

#define LDS_WAIT() asm volatile("s_waitcnt lgkmcnt(0)" ::: "memory")
#define VM_WAIT() asm volatile("s_waitcnt vmcnt(0)" ::: "memory")
__device__ __forceinline__ unsigned f2bf(float f) { unsigned u = __builtin_bit_cast(unsigned, f); return (u + 0x7fffu + ((u >> 16) & 1u)) >> 16; }
__device__ __forceinline__ unsigned pk2(float lo, float hi) { return f2bf(lo) | (f2bf(hi) << 16); }
__device__ __forceinline__ float bf2f(unsigned short b) { return __builtin_bit_cast(float, (unsigned)b << 16); }
__device__ __forceinline__ float wave_sum(float v) {
#pragma unroll
    for (int o = 1; o < 64; o <<= 1) v += __shfl_xor(v, o);
    return v;
}

#define XB_TMO      128
#define XB_XCNT(j)  (256  + 64 * (j))
#define XB_XSUB(j)  (1280 + 64 * (j))
#define XB_XGEN(j)  (2304 + 64 * (j))
#define XB_TOP      3328
#define XB_TOPGEN   3392
#define XCD_BAR_WORDS 3456
#define XB_SPIN_CAP (1u << 22)
__device__ __forceinline__ unsigned xb_ld(unsigned* p)              { return __hip_atomic_load(p, __ATOMIC_RELAXED, __HIP_MEMORY_SCOPE_AGENT); }
__device__ __forceinline__ unsigned xb_add(unsigned* p, unsigned v) { return __hip_atomic_fetch_add(p, v, __ATOMIC_RELAXED, __HIP_MEMORY_SCOPE_AGENT); }
__device__ __forceinline__ unsigned xb_xcc_id() { return (unsigned)__builtin_amdgcn_s_getreg((3 << 11) | 20) & 0xFu; }
#define XB_SPIN(cond, bar) do { unsigned _sp = 0; while (cond) { __builtin_amdgcn_s_sleep(1); \
    if ((++_sp & 255u) == 0u) { if (xb_ld(&(bar)[XB_TMO])) break; if (_sp > XB_SPIN_CAP) { atomicAdd(&(bar)[XB_TMO], 1u); break; } } } } while (0)
struct XcdBarrier { unsigned* bar; unsigned x; volatile LAS unsigned* st; };
__device__ __forceinline__ XcdBarrier xcd_barrier_post(unsigned* bar, volatile LAS unsigned* st) {
    XcdBarrier b; b.bar = bar; b.x = xb_xcc_id(); b.st = st;
    if (threadIdx.x == 0) (void)xb_add(&bar[XB_XCNT(b.x)], 1u);
    return b;
}
__device__ __forceinline__ void xcd_barrier_complete(unsigned* bar, unsigned x, unsigned& nloc, unsigned& nx) {
    const unsigned G = gridDim.x * gridDim.y * gridDim.z;
    unsigned sum, cnt, mine, sp = 0u;
    for (;;) {
        sum = 0u; cnt = 0u; mine = 0u;
#pragma unroll
        for (unsigned j = 0; j < 16; ++j) { const unsigned c = xb_ld(&bar[XB_XCNT(j)]); sum += c; cnt += (c > 0u) ? 1u : 0u; mine = (j == x) ? c : mine; }
        if (sum == G) break;
        __builtin_amdgcn_s_sleep(1);
        if ((++sp & 255u) == 0u) { if (xb_ld(&bar[XB_TMO])) break; if (sp > XB_SPIN_CAP) { atomicAdd(&bar[XB_TMO], 1u); break; } }
    }
    nloc = mine > 0u ? mine : 1u; nx = cnt > 0u ? cnt : 1u;
}
__device__ __forceinline__ void xcd_barrier(const XcdBarrier& b) {
    asm volatile("s_waitcnt vmcnt(0)" ::: "memory");
    __syncthreads();
    if (threadIdx.x == 0) {
        unsigned* bar = b.bar;
        __builtin_amdgcn_s_waitcnt(0);
        unsigned nloc = b.st[0], nx = b.st[1];
        if (nloc == 0u) { xcd_barrier_complete(bar, b.x, nloc, nx); b.st[0] = nloc; b.st[1] = nx; }
        const unsigned old = xb_add(&bar[XB_XSUB(b.x)], 1u);
        const unsigned gen = old / nloc;
        if (old + 1u == (gen + 1u) * nloc) {
            __builtin_amdgcn_fence(__ATOMIC_RELEASE, "agent");
            asm volatile("s_waitcnt vmcnt(0)" ::: "memory");
            const unsigned og = xb_add(&bar[XB_TOP], 1u);
            const unsigned tg = og / nx;
            if (og + 1u == (tg + 1u) * nx) xb_add(&bar[XB_TOPGEN], 1u);
            else XB_SPIN(xb_ld(&bar[XB_TOPGEN]) == tg, bar);
            __builtin_amdgcn_fence(__ATOMIC_ACQUIRE, "agent");
            xb_add(&bar[XB_XGEN(b.x)], 1u);
            asm volatile("s_waitcnt vmcnt(0)" ::: "memory");
        } else {
            XB_SPIN(xb_ld(&bar[XB_XGEN(b.x)]) == gen, bar);
            __builtin_amdgcn_fence(__ATOMIC_ACQUIRE, "agent");
            asm volatile("s_waitcnt vmcnt(0)" ::: "memory");
        }
    }
    __syncthreads();
}

__device__ __forceinline__ void grid_barrier(unsigned char* ws, LAS unsigned char* lds) {
    XcdBarrier b; b.bar = (unsigned*)(ws + WS_BAR); b.x = xb_xcc_id(); b.st = (volatile LAS unsigned*)(lds + MISC_OFF); xcd_barrier(b);
}
struct EpiNormRes {
    static constexpr bool PERM = true, AFTER_DRAIN = true; static constexpr int RS = 0;
    const float* x; float* xout; const float* norm_gains; unsigned char* ws; int idx, goff, first, last; float coef;
    __device__ __forceinline__ void rowstat(const f32x4 (&acc)[2][2][4][2], const pg8::Unit& u, int wr, int wc, int fr, int fq, LAS unsigned char* lds, float* slots) const {
        LAS float* P = (LAS float*)lds;
#pragma unroll
        for (int ai = 0; ai < 2; ++ai)
#pragma unroll
            for (int m = 0; m < 4; ++m) { float s = 0.f;
#pragma unroll
                for (int bj = 0; bj < 2; ++bj)
#pragma unroll
                    for (int n = 0; n < 2; ++n) { const f32x4 v = acc[ai][bj][m][n]; s += (v.x * v.x + v.y * v.y) + (v.z * v.z + v.w * v.w); }
                s += __shfl_xor(s, 16); s += __shfl_xor(s, 32);
                if (fq == 0) P[(ai * 128 + wr * 64 + m * 16 + fr) * 4 + wc] = s; }
        LDS_WAIT(); __syncthreads();
        if (slots && threadIdx.x < 256) { const f32x4 p = *(const LAS f32x4*)(P + threadIdx.x * 4); slots[(size_t)(u.pm * 256 + threadIdx.x) * 8 + u.pn] = (p.x + p.y) + (p.z + p.w); }
    }
    __device__ __forceinline__ void rowrs(const pg8::Unit& u, LAS unsigned char* lds, const float* slots) const {
        LAS float* S = (LAS float*)(lds + 4096);
        if (threadIdx.x < 256) { const f32x4* sp = (const f32x4*)(slots + (size_t)(u.pm * 256 + threadIdx.x) * 8); const f32x4 a = sp[0], b = sp[1];
            const float t = ((a.x + a.y) + (a.z + a.w)) + ((b.x + b.y) + (b.z + b.w)); S[threadIdx.x] = 1.0f / sqrtf(t * (1.0f / D) + RMS_EPS); }
        LDS_WAIT(); __syncthreads();
    }
    __device__ __forceinline__ void publish(const pg8::Unit& u, LAS unsigned char* lds, float* slots) const {
        const LAS float* P = (const LAS float*)lds;
        unsigned* cnt = (unsigned*)(ws + WS_BAR + 16384) + (size_t)(idx * 32 + u.pm) * 64;
        if (threadIdx.x < 256) { const f32x4 p = *(const LAS f32x4*)(P + threadIdx.x * 4);
            __hip_atomic_store((unsigned*)(slots + (size_t)(u.pm * 256 + threadIdx.x) * 8 + u.pn), __builtin_bit_cast(unsigned, (p.x + p.y) + (p.z + p.w)), __ATOMIC_RELAXED, __HIP_MEMORY_SCOPE_AGENT);
            asm volatile("s_waitcnt vmcnt(0)" ::: "memory");
            if ((threadIdx.x & 63) == 0) (void)__hip_atomic_fetch_add(cnt, 1u, __ATOMIC_RELAXED, __HIP_MEMORY_SCOPE_AGENT); }
    }
    __device__ __forceinline__ void wait_read(const pg8::Unit& u, LAS unsigned char* lds, const float* slots) const {
        unsigned* cnt = (unsigned*)(ws + WS_BAR + 16384) + (size_t)(idx * 32 + u.pm) * 64;
        if (threadIdx.x < 64) { unsigned sp = 0;
            while ((unsigned)__builtin_amdgcn_readfirstlane(__hip_atomic_load(cnt, __ATOMIC_RELAXED, __HIP_MEMORY_SCOPE_AGENT)) < 32u) { __builtin_amdgcn_s_sleep(2); if (++sp > (1u << 22)) break; }
            __builtin_amdgcn_fence(__ATOMIC_ACQUIRE, "agent");
            asm volatile("s_waitcnt vmcnt(0)" ::: "memory"); }
        __syncthreads();
        LAS float* S = (LAS float*)(lds + 4096);
        if (threadIdx.x < 256) { const f32x4* sp = (const f32x4*)(slots + (size_t)(u.pm * 256 + threadIdx.x) * 8); const f32x4 pa = sp[0], pb = sp[1];
            const float t = ((pa.x + pa.y) + (pa.z + pa.w)) + ((pb.x + pb.y) + (pb.z + pb.w));
            S[threadIdx.x] = 1.0f / sqrtf(t * (1.0f / D) + RMS_EPS); }
        LDS_WAIT(); __syncthreads();
    }
    __device__ __forceinline__ void fused(f32x4 (&acc)[2][2][4][2], const pg8::Unit& u, int wr, int wc, int fr, int fq, LAS unsigned char* lds) const {
        const LAS float* S = (const LAS float*)(lds + 4096);
        float* sl1 = (float*)(ws + WS_SLOTS + (size_t)(2 * idx) * SZ_SLOT); float* sl2 = sl1 + SZ_SLOT / 4;
        const float* gpost = norm_gains + goff; bf16_t* XN = (bf16_t*)(ws + WS_XN);
        rowstat(acc, u, wr, wc, fr, fq, lds, nullptr);
        publish(u, lds, sl1);
        const int col0 = u.pn * 256 + wc * 32 + 8 * fq;
        u32x4 xw[2][4][2];
#pragma unroll
        for (int ai = 0; ai < 2; ++ai)
#pragma unroll
            for (int m = 0; m < 4; ++m)
#pragma unroll
                for (int bj = 0; bj < 2; ++bj) xw[ai][m][bj] = *(const u32x4*)(XN + (size_t)(u.pm * 256 + ai * 128 + wr * 64 + m * 16 + fr) * D + col0 + bj * 128);
        f32x4 gv[2][2];
#pragma unroll
        for (int bj = 0; bj < 2; ++bj)
#pragma unroll
            for (int n = 0; n < 2; ++n) gv[bj][n] = *(const f32x4*)(gpost + col0 + bj * 128 + n * 4) * coef;
        wait_read(u, lds, sl1);
#pragma unroll
        for (int ai = 0; ai < 2; ++ai)
#pragma unroll
            for (int m = 0; m < 4; ++m) { const int r = ai * 128 + wr * 64 + m * 16 + fr; const float rs = S[r]; const size_t off = (size_t)(u.pm * 256 + r) * D + col0;
#pragma unroll
                for (int bj = 0; bj < 2; ++bj) { const u32x4 w = xw[ai][m][bj];
                    const f32x4 xv0 = (f32x4){__builtin_bit_cast(float, w.x << 16), __builtin_bit_cast(float, w.x & 0xffff0000u), __builtin_bit_cast(float, w.y << 16), __builtin_bit_cast(float, w.y & 0xffff0000u)};
                    const f32x4 xv1 = (f32x4){__builtin_bit_cast(float, w.z << 16), __builtin_bit_cast(float, w.z & 0xffff0000u), __builtin_bit_cast(float, w.w << 16), __builtin_bit_cast(float, w.w & 0xffff0000u)};
                    const f32x4 xn0 = xv0 + (acc[ai][bj][m][0] * rs) * gv[bj][0], xn1 = xv1 + (acc[ai][bj][m][1] * rs) * gv[bj][1];
                    if (last) { *(f32x4*)(xout + off + bj * 128) = xn0; *(f32x4*)(xout + off + bj * 128 + 4) = xn1; }
                    acc[ai][bj][m][0] = xn0; acc[ai][bj][m][1] = xn1; } }
        if (last) return;
#pragma unroll
        for (int ai = 0; ai < 2; ++ai)
#pragma unroll
            for (int m = 0; m < 4; ++m) { const int r = ai * 128 + wr * 64 + m * 16 + fr; bf16_t* xo = XN + (size_t)(u.pm * 256 + r) * D + col0;
#pragma unroll
                for (int bj = 0; bj < 2; ++bj) { const f32x4 v0 = acc[ai][bj][m][0], v1 = acc[ai][bj][m][1];
                    u32x4 w; w.x = pg8::cvt_pk_bf16(v0.x, v0.y); w.y = pg8::cvt_pk_bf16(v0.z, v0.w); w.z = pg8::cvt_pk_bf16(v1.x, v1.y); w.w = pg8::cvt_pk_bf16(v1.z, v1.w);
                    *(u32x4*)(xo + bj * 128) = w; } }
        rowstat(acc, u, wr, wc, fr, fq, lds, sl2);
    }
};

struct Frame {
    LAS unsigned char* lds;
    int tid, lane, wave, vcu, G;
};

__device__ __forceinline__ void p0_transpose_item(const float* W, int K, int N, bf16_t* WT, const float* gain, const float* cscale, int mode, int row_off, LAS unsigned char* scr, int item, int lane) {
    const int nblk = N / 64, kb = item / nblk, nb = item % nblk, k0 = 64 * kb, n0 = 64 * nb;
    const int lq = lane >> 4, ln = lane & 15;
    const float* src = W + (size_t)(k0 + 4 * lq) * N + n0 + 4 * ln;
    f32x4 v[16];
#pragma unroll
    for (int j = 0; j < 4; ++j)
#pragma unroll
        for (int r = 0; r < 4; ++r) v[4 * j + r] = __builtin_nontemporal_load((const f32x4*)(src + (size_t)(16 * j + r) * N));
    const f32x4 cs = cscale ? *(const f32x4*)(cscale + n0 + 4 * ln) : (f32x4){1.f, 1.f, 1.f, 1.f};
#pragma unroll
    for (int j = 0; j < 4; ++j) {
        const f32x4 g4 = gain ? *(const f32x4*)(gain + k0 + 16 * j + 4 * lq) : (f32x4){1.f, 1.f, 1.f, 1.f};
        const f32x4 r0 = v[4 * j + 0] * cs * g4.x, r1 = v[4 * j + 1] * cs * g4.y, r2 = v[4 * j + 2] * cs * g4.z, r3 = v[4 * j + 3] * cs * g4.w;
#pragma unroll
        for (int i = 0; i < 4; ++i) { u32x2 w; w.x = pg8::cvt_pk_bf16(r0[i], r1[i]); w.y = pg8::cvt_pk_bf16(r2[i], r3[i]);
            *(LAS u32x2*)(scr + (4 * ln + i) * 144 + (16 * j + 4 * lq) * 2) = w; }
    }
    LDS_WAIT(); asm volatile("" ::: "memory");
    const int rbase = (mode == 0) ? (row_off + n0) : ((n0 >> 7) * 256 + (n0 & 127) + (mode == 2 ? 128 : 0));
    const int c = lane & 7;
#pragma unroll
    for (int q = 0; q < 8; ++q) { const int n = (lane >> 3) + 8 * q;
        const u32x4 o = *(const LAS u32x4*)(scr + n * 144 + c * 16);
        *(u32x4*)(WT + (size_t)(rbase + n) * K + k0 + 8 * c) = o; }
    LDS_WAIT(); asm volatile("" ::: "memory");
}

__device__ __forceinline__ int t5_bucket(int rel) {
    const int n = rel < 0 ? -rel : rel;
    const int v = n < 8 ? n : n < 12 ? 8 : n < 16 ? 9 : n < 23 ? 10 : n < 32 ? 11 : n < 46 ? 12 : n < 64 ? 13 : n < 91 ? 14 : 15;
    return (rel > 0 ? 16 : 0) + v;
}

struct Args {
    const float *x, *norm_gains, *wg, *wu, *wd, *pool_w, *pool_scale, *kv_norm, *w_k, *w_v, *rel_bias, *w_q, *w_o, *lambdas, *subln;
    float* out; unsigned char* ws; int ph_lo, ph_hi;
};

__device__ __forceinline__ const float* gains(const Args& a, int l, int sub, int pp) { return a.norm_gains + (size_t)((l * 3 + sub) * 2 + pp) * D; }

__device__ __forceinline__ void store_xraw(const f32x4 (&v)[8], bf16_t* orow, float* slot8, int lane) {
    float s = 0.f;
#pragma unroll
    for (int j = 0; j < 8; ++j) s += (v[j].x * v[j].x + v[j].y * v[j].y) + (v[j].z * v[j].z + v[j].w * v[j].w);
    s = wave_sum(s);
    u32x2* o8 = (u32x2*)orow + lane;
#pragma unroll
    for (int j = 0; j < 8; ++j) { u32x2 w; w.x = pg8::cvt_pk_bf16(v[j].x, v[j].y); w.y = pg8::cvt_pk_bf16(v[j].z, v[j].w); o8[64 * j] = w; }
    if (lane == 0) { *(f32x4*)slot8 = (f32x4){s, 0.f, 0.f, 0.f}; *(f32x4*)(slot8 + 4) = (f32x4){0.f, 0.f, 0.f, 0.f}; }
}

__device__ __forceinline__ void p0_prologue(Frame& F, const Args& a) {
    LAS unsigned char* scr = F.lds + F.wave * 16384;
    const int gw = F.vcu * NWAVES + F.wave, NGW = F.G * NWAVES;
    unsigned char* ws = a.ws;
    constexpr int I_FFN = (D / 64) * (DFF / 64);
    constexpr int I_SQ = (D / 64) * (D / 64);
    constexpr int I_PG = (512 / 64) * (512 / 64);
    constexpr int NITEMS = 8 * I_FFN;
    {
#define P0_SRC(it_) (((((it_) / I_FFN) & 1) == 0 ? a.wg : a.wu) + (size_t)(((it_) / I_FFN) >> 1) * D * DFF)
#define P0_LOAD(v, it_) do { const int item = (it_) % I_FFN, kb = item % (D / 64), nb = item / (D / 64); const float* src = P0_SRC(it_) + (size_t)(64 * kb + 4 * (F.lane >> 4)) * DFF + 64 * nb + 4 * (F.lane & 15); \
        _Pragma("unroll") for (int j = 0; j < 4; ++j) _Pragma("unroll") for (int r = 0; r < 4; ++r) v[4 * j + r] = __builtin_nontemporal_load((const f32x4*)(src + (size_t)(16 * j + r) * DFF)); } while (0)
#define P0_FINISH(v, it_) do { const int mat = (it_) / I_FFN, lf = mat >> 1, kind = mat & 1, item = (it_) % I_FFN, kb = item % (D / 64), nb = item / (D / 64), k0 = 64 * kb, n0 = 64 * nb; \
        const int lq = F.lane >> 4, ln = F.lane & 15; const float* gain = gains(a, lf >> 1, 2 * (lf & 1), 0); bf16_t* WT = (bf16_t*)(ws + WS_WGU + lf * SZ_WGU); \
        _Pragma("unroll") for (int j = 0; j < 4; ++j) { const f32x4 g4 = *(const f32x4*)(gain + k0 + 16 * j + 4 * lq); \
            const f32x4 r0 = v[4 * j + 0] * g4.x, r1 = v[4 * j + 1] * g4.y, r2 = v[4 * j + 2] * g4.z, r3 = v[4 * j + 3] * g4.w; \
            _Pragma("unroll") for (int i = 0; i < 4; ++i) { u32x2 w; w.x = pg8::cvt_pk_bf16(r0[i], r1[i]); w.y = pg8::cvt_pk_bf16(r2[i], r3[i]); *(LAS u32x2*)(scr + (4 * ln + i) * 144 + (16 * j + 4 * lq) * 2) = w; } } \
        LDS_WAIT(); asm volatile("" ::: "memory"); \
        const int rbase = (n0 >> 7) * 256 + (n0 & 127) + (kind ? 128 : 0), cc = F.lane & 7; \
        _Pragma("unroll") for (int q = 0; q < 8; ++q) { const int n = (F.lane >> 3) + 8 * q; const u32x4 o = *(const LAS u32x4*)(scr + n * 144 + cc * 16); *(u32x4*)(WT + (size_t)(rbase + n) * D + k0 + 8 * cc) = o; } \
        LDS_WAIT(); asm volatile("" ::: "memory"); } while (0)
        f32x4 vA[16], vB[16]; int it = gw;
        if (it < NITEMS) P0_LOAD(vA, it);
        while (it < NITEMS) {
            int nx = it + NGW;
            if (nx < NITEMS) P0_LOAD(vB, nx);
            P0_FINISH(vA, it);
            it = nx; if (it >= NITEMS) break;
            nx = it + NGW;
            if (nx < NITEMS) P0_LOAD(vA, nx);
            P0_FINISH(vB, it);
            it = nx;
        }
#undef P0_SRC
#undef P0_LOAD
#undef P0_FINISH
    }
    for (int m = gw; m < M; m += NGW) {
        const f32x4* xr = (const f32x4*)(a.x + (size_t)m * D) + F.lane; f32x4 v[8];
#pragma unroll
        for (int j = 0; j < 8; ++j) v[j] = __builtin_nontemporal_load(xr + 64 * j);
        store_xraw(v, (bf16_t*)(ws + WS_XN) + (size_t)m * D, (float*)(ws + WS_SLOTS + 12 * SZ_SLOT) + (size_t)m * 8, F.lane);
    }
    float* lut = (float*)(ws + WS_LUT);
    for (int i = blockIdx.x * 512 + F.tid; i < 16 * 256; i += F.G * 512) { const int mp = i >> 8, rel = (i & 255) - 192;
        lut[i] = (a.rel_bias[t5_bucket(rel) * 16 + mp] - a.rel_bias[15 * 16 + mp]) * LOG2E; }
    if (blockIdx.x == 0 && F.wave == 0) { const float* L = a.lambdas; const int lane = F.lane;
        const float s1 = wave_sum(L[lane] * L[128 + lane] + L[64 + lane] * L[192 + lane]);
        const float s2 = wave_sum(L[256 + lane] * L[384 + lane] + L[320 + lane] * L[448 + lane]);
        if (lane == 0) lut[4096] = expf(s1) - expf(s2) + LAMBDA_INIT; }
}

__device__ __forceinline__ void convert_wd_idle(Frame& F, const Args& a, int lf, int extra) {
    const int half = F.G >> 1;
    if ((int)blockIdx.x < half) return;
    constexpr int I_FFN = (D / 64) * (DFF / 64), I_SQ = (D / 64) * (D / 64), I_PG = (512 / 64) * (512 / 64);
    LAS unsigned char* scr = F.lds + F.wave * 16384;
    const int w0 = ((int)blockIdx.x - half) * NWAVES + F.wave, nw = (F.G - half) * NWAVES;
    for (int it = w0; it < I_FFN; it += nw)
        p0_transpose_item(a.wd + (size_t)lf * DFF * D, DFF, D, (bf16_t*)(a.ws + WS_WD + lf * SZ_WD), nullptr, nullptr, 0, 0, scr, it, F.lane);
#pragma unroll
    for (int w = 0; w < 4; ++w) if (extra & (2 << w)) {
        const float* W = w == 0 ? a.w_k : w == 1 ? a.w_v : w == 2 ? a.w_q : a.w_o;
        const float* gn = w < 2 ? a.kv_norm : w == 2 ? gains(a, 1, 1, 0) : nullptr;
        for (int it = w0; it < I_SQ; it += nw) p0_transpose_item(W, D, D, (bf16_t*)(a.ws + WS_WK + w * SZ_SQ), gn, nullptr, 0, 0, scr, it, F.lane); }
    if (extra & 1) for (int it = w0; it < 4 * I_PG; it += nw) { const int gi = it / I_PG;
        p0_transpose_item(a.pool_w + (size_t)gi * 512 * 512, 512, 512, (bf16_t*)(a.ws + WS_POOL), gains(a, 0, 1, 0) + gi * 512, a.pool_scale + gi * 512, 0, gi * 512, scr, it % I_PG, F.lane); }
}

__device__ __forceinline__ void pool_phase(Frame& F, const bf16_t* XN, const float* rsl, bf16_t* DP) {
    const int NIT = (M / 16) * 256;
    LAS float* T = (LAS float*)F.lds;
    for (int base = blockIdx.x * 512; base < NIT; base += F.G * 512) {
        const int r0 = (base >> 8) * 16 - 16;
        if (F.tid < 48) { const int row = r0 + F.tid; float v = 0.f;
            if (row >= 0) { const f32x4* sp = (const f32x4*)(rsl + (size_t)row * 8); const f32x4 a = sp[0], b = sp[1];
                const float t = ((a.x + a.y) + (a.z + a.w)) + ((b.x + b.y) + (b.z + b.w)); v = 1.0f / sqrtf(t * (1.0f / D) + RMS_EPS); }
            T[F.tid] = v; }
        LDS_WAIT(); __syncthreads();
        const int it = base + F.tid;
        const int o = it & 255, s = it >> 8, m0 = s * 16, t0 = m0 & (SEQ - 1), gi = o >> 6, win = 2 << gi;
        const bf16_t* bp = XN + (size_t)m0 * D + o * 8;
        const LAS float* Tm = T + (m0 - r0);
        float sum[8];
#pragma unroll
        for (int e = 0; e < 8; ++e) sum[e] = 0.f;
#define POOL_ACC(op, v, sc) do { sum[0] op __builtin_bit_cast(float, (v).x << 16) * (sc); sum[1] op __builtin_bit_cast(float, (v).x & 0xffff0000u) * (sc); sum[2] op __builtin_bit_cast(float, (v).y << 16) * (sc); sum[3] op __builtin_bit_cast(float, (v).y & 0xffff0000u) * (sc); \
        sum[4] op __builtin_bit_cast(float, (v).z << 16) * (sc); sum[5] op __builtin_bit_cast(float, (v).z & 0xffff0000u) * (sc); sum[6] op __builtin_bit_cast(float, (v).w << 16) * (sc); sum[7] op __builtin_bit_cast(float, (v).w & 0xffff0000u) * (sc); } while (0)
        for (int i = 1; i < win; ++i) if (t0 - i >= 0) { const u32x4 v = *(const u32x4*)(bp - (ptrdiff_t)i * D); const float sc = Tm[-i]; POOL_ACC(+=, v, sc); }
        for (int t = 0; t < 16; ++t) {
            const u32x4 v = *(const u32x4*)(bp + (size_t)t * D); const float sc = Tm[t];
            float c[8] = { __builtin_bit_cast(float, v.x << 16) * sc, __builtin_bit_cast(float, v.x & 0xffff0000u) * sc, __builtin_bit_cast(float, v.y << 16) * sc, __builtin_bit_cast(float, v.y & 0xffff0000u) * sc,
                           __builtin_bit_cast(float, v.z << 16) * sc, __builtin_bit_cast(float, v.z & 0xffff0000u) * sc, __builtin_bit_cast(float, v.w << 16) * sc, __builtin_bit_cast(float, v.w & 0xffff0000u) * sc };
#pragma unroll
            for (int e = 0; e < 8; ++e) sum[e] += c[e];
            const int tt = t0 + t;
            const float inv = 1.0f / (float)((tt + 1 < win) ? tt + 1 : win);
            u32x4 ov; ov.x = pg8::cvt_pk_bf16(sum[0] * inv - c[0], sum[1] * inv - c[1]); ov.y = pg8::cvt_pk_bf16(sum[2] * inv - c[2], sum[3] * inv - c[3]);
            ov.z = pg8::cvt_pk_bf16(sum[4] * inv - c[4], sum[5] * inv - c[5]); ov.w = pg8::cvt_pk_bf16(sum[6] * inv - c[6], sum[7] * inv - c[7]);
            if (tt + 1 - win >= 0) { const u32x4 w = *(const u32x4*)(bp + (ptrdiff_t)(t + 1 - win) * D); const float sw = Tm[t + 1 - win]; POOL_ACC(-=, w, sw); }
            *(u32x4*)(DP + (size_t)(m0 + t) * D + o * 8) = ov;
        }
#undef POOL_ACC
        __syncthreads();
    }
}

template <int MODE>
__device__ __forceinline__ void attn_phase(Frame& F, const bf16_t* Q, const bf16_t* Kb, const bf16_t* VT, bf16_t* O, const float* lutg, const float* subln) {
    LAS unsigned char* lds = F.lds;
    const int lane = F.lane, wid = F.wave, i16 = lane & 15, a = lane >> 4, c = wid >> 2, qg = wid & 3;
    LAS float* lut = (LAS float*)(lds + LUT_OFF);
    unsigned koff0, voff0;
    { const int rk = 2 * (wid & 1) + 8 * (wid >> 1) + (lane >> 5); const int chk = (lane & 31) ^ ((rk & 3) | (((rk >> 3) & 3) << 2)); koff0 = (unsigned)(rk * D + chk * 8) * 2u;
      const int rv = 8 * wid + (lane >> 3); const int chv = (lane & 7) ^ ((rv >> 1) & 7); voff0 = (unsigned)(rv * M + chv * 8) * 2u; }
#define ATT_STAGE_B(kb_, vb_, t, buf) do { const char* _kb = (kb_) + (size_t)(t) * (64 * D * 2); const char* _vb = (vb_) + (size_t)(t) * 128; \
        _Pragma("unroll") for (int _i = 0; _i < 4; ++_i) \
            __builtin_amdgcn_global_load_lds((const unsigned*)(_kb + (size_t)((4 * (_i & 1) + 32 * (_i >> 1)) * D * 2) + koff0), (LAS unsigned*)(lds + (buf) * 32768 + ((_i & 1) * 2 + (_i >> 1) * 16 + (wid & 1) + (wid >> 1) * 4) * 1024), 16, 0, 0); \
        _Pragma("unroll") for (int _i = 0; _i < 4; ++_i) \
            __builtin_amdgcn_global_load_lds((const unsigned*)(_vb + (size_t)(64 * _i) * M * 2 + voff0), (LAS unsigned*)(lds + 65536 + (buf) * 32768 + (wid + 8 * _i) * 1024), 16, 0, 0); } while (0)
#define ATT_STAGE(t, buf) ATT_STAGE_B(kbase, vbase, t, buf)
#define ATT_SETUP(u_, NT, QPOS0, MQ0, HH, KB, VB) do { const int P = (u_) & 255, rnd = (u_) >> 8, bh = P >> 3, jj = P & 7, b_ = bh >> 3, h_ = bh & 7; \
        const int q64 = rnd == 0 ? 31 - jj : rnd == 1 ? jj : rnd == 2 ? 23 - jj : 8 + jj; \
        NT = q64 + 1; QPOS0 = q64 * 64 + qg * 16; MQ0 = b_ * SEQ + QPOS0; HH = h_; \
        KB = (const char*)(Kb + (size_t)(b_ * SEQ) * D + h_ * 256); VB = (const char*)(VT + (size_t)(h_ * 256) * M + b_ * SEQ); \
        lut[F.tid] = lutg[(2 * h_ + (F.tid >> 8)) * 256 + (F.tid & 255)]; \
        _Pragma("unroll") for (int ks = 0; ks < 4; ++ks) qf[ks] = *(const bf16x8*)(Q + (size_t)(MQ0 + i16) * D + h_ * 256 + c * 128 + ks * 32 + a * 8); \
        ATT_STAGE_B(KB, VB, 0, 0); } while (0)
    int u = F.vcu;
    if (u < 1024) {
      bf16x8 qf[4]; int nt, qpos0, mq0, h; const char* kbase; const char* vbase;
      ATT_SETUP(u, nt, qpos0, mq0, h, kbase, vbase);
      for (;;) {
        f32x4 o[16];
#pragma unroll
        for (int d = 0; d < 16; ++d) o[d] = (f32x4){0.f, 0.f, 0.f, 0.f};
        float mrow = -1e30f, lrow = 0.f;
        for (int t = 0; t < nt; ++t) {
            const int buf = t & 1;
            VM_WAIT(); LDS_WAIT(); __builtin_amdgcn_s_barrier(); asm volatile("" ::: "memory");
            if (t + 1 < nt && MODE != 1) ATT_STAGE(t + 1, buf ^ 1);
            if (MODE == 2) continue;
            const LAS unsigned char* kb = lds + buf * 32768; const LAS unsigned char* vb = lds + 65536 + buf * 32768;
            const bool nearb = (t * 64 + 63 - qpos0) > -91;
            bf16x8 fr[16];
            f32x4 st[4];
#pragma unroll
            for (int kg = 0; kg < 4; ++kg) {
                const int row = 32 * (kg >> 1) + 8 * (i16 >> 2) + 4 * (kg & 1) + (i16 & 3);
#pragma unroll
                for (int ks = 0; ks < 4; ++ks) { const int ch = (c * 16 + ks * 4 + a) ^ i16; fr[kg * 4 + ks] = *(const LAS bf16x8*)(kb + row * 512 + ch * 16); } }
            __builtin_amdgcn_sched_barrier(0);
#pragma unroll
            for (int kg = 0; kg < 4; ++kg) { st[kg] = (f32x4){0.f, 0.f, 0.f, 0.f};
#pragma unroll
                for (int ks = 0; ks < 4; ++ks) st[kg] = __builtin_amdgcn_mfma_f32_16x16x32_bf16(fr[kg * 4 + ks], qf[ks], st[kg], 0, 0, 0); }
            __builtin_amdgcn_sched_barrier(0);
#define ATT_VLOAD(b, base) do { _Pragma("unroll") for (int _d = 0; _d < 4; ++_d) _Pragma("unroll") for (int _p = 0; _p < 2; ++_p) { const int ch = (4 * _p + a) ^ ((i16 >> 1) & 7); \
                fr[(base) + _d * 2 + _p] = *(const LAS bf16x8*)(vb + (((b) * 4 + _d) * 16 + i16) * 128 + ch * 16); } } while (0)
            ATT_VLOAD(0, 0);
            __builtin_amdgcn_sched_barrier(0);
            if (nearb) {
#pragma unroll
                for (int kg = 0; kg < 4; ++kg)
#pragma unroll
                    for (int j = 0; j < 4; ++j) { const int keyloc = 32 * (kg >> 1) + 8 * a + 4 * (kg & 1) + j; int idx = t * 64 + keyloc - (qpos0 + i16) + 192; idx = idx < 0 ? 0 : idx;
                        st[kg][j] += lut[c * 256 + idx]; }
            }
#define MAX3(a_, b_, c_) fmaxf(fmaxf((a_), (b_)), (c_))
            float mx = MAX3(st[0][0], st[0][1], st[0][2]); mx = MAX3(mx, st[0][3], st[1][0]); mx = MAX3(mx, st[1][1], st[1][2]); mx = MAX3(mx, st[1][3], st[2][0]);
            mx = MAX3(mx, st[2][1], st[2][2]); mx = MAX3(mx, st[2][3], st[3][0]); mx = MAX3(mx, st[3][1], st[3][2]); mx = fmaxf(mx, st[3][3]);
#undef MAX3
            float mnew = mrow, alpha = 1.0f;
            if (__builtin_amdgcn_ballot_w64(mx > mrow + 8.0f) != 0ull) {
                mx = fmaxf(mx, __shfl_xor(mx, 16)); mx = fmaxf(mx, __shfl_xor(mx, 32));
                mnew = fmaxf(mrow, mx); alpha = __builtin_amdgcn_exp2f(mrow - mnew); mrow = mnew; }
            float psum = 0.f;
#pragma unroll
            for (int kg = 0; kg < 4; ++kg)
#pragma unroll
                for (int j = 0; j < 4; ++j) { const float p = __builtin_amdgcn_exp2f(st[kg][j] - mnew); psum += p; st[kg][j] = p; }
            lrow = lrow * alpha + psum;
            if (__builtin_amdgcn_ballot_w64(alpha != 1.0f) != 0ull) {
#pragma unroll
                for (int d = 0; d < 16; ++d) o[d] = o[d] * alpha;
            }
            bf16x8 pf[2];
#pragma unroll
            for (int p = 0; p < 2; ++p) { u32x4 w; w.x = pg8::cvt_pk_bf16(st[2 * p][0], st[2 * p][1]); w.y = pg8::cvt_pk_bf16(st[2 * p][2], st[2 * p][3]);
                w.z = pg8::cvt_pk_bf16(st[2 * p + 1][0], st[2 * p + 1][1]); w.w = pg8::cvt_pk_bf16(st[2 * p + 1][2], st[2 * p + 1][3]); pf[p] = __builtin_bit_cast(bf16x8, w); }
            __builtin_amdgcn_sched_barrier(0);
#pragma unroll
            for (int b = 0; b < 4; ++b) {
                if (b < 3) { if (b == 0) ATT_VLOAD(1, 8); else if (b == 1) ATT_VLOAD(2, 0); else ATT_VLOAD(3, 8); }
                __builtin_amdgcn_sched_barrier(0);
#pragma unroll
                for (int d = 0; d < 4; ++d)
#pragma unroll
                    for (int p = 0; p < 2; ++p) o[b * 4 + d] = __builtin_amdgcn_mfma_f32_16x16x32_bf16(fr[(b & 1) * 8 + d * 2 + p], pf[p], o[b * 4 + d], 0, 0, 0);
                __builtin_amdgcn_sched_barrier(0);
            }
#undef ATT_VLOAD
        }
        float lt = lrow; lt += __shfl_xor(lt, 16); lt += __shfl_xor(lt, 32);
        LDS_WAIT(); __builtin_amdgcn_s_barrier(); asm volatile("" ::: "memory");
        const int mq0_c = mq0, h_c = h; const int un = u + F.G; const bool has_next = un < 1024;
        if (has_next) { ATT_SETUP(un, nt, qpos0, mq0, h, kbase, vbase); }
        LAS f32x4* xch = (LAS f32x4*)(lds + (qg < 2 ? 32768 + qg * 16384 : 98304 + (qg - 2) * 16384)) + lane;
        if (c == 1) { const float k1 = lutg[4096] / lt;
#pragma unroll
            for (int d = 0; d < 16; ++d) xch[d * 64] = o[d] * k1; }
        LDS_WAIT(); __builtin_amdgcn_s_barrier(); asm volatile("" ::: "memory");
        if (c == 0) {
            const float inv0 = 1.0f / lt; float ss = 0.f;
#pragma unroll
            for (int d = 0; d < 16; ++d) { const f32x4 v = o[d] * inv0 - xch[d * 64]; o[d] = v; ss += (v.x * v.x + v.y * v.y) + (v.z * v.z + v.w * v.w); }
            ss += __shfl_xor(ss, 16); ss += __shfl_xor(ss, 32);
            const float r = (1.0f - LAMBDA_INIT) / sqrtf(ss * (1.0f / 256.0f) + SUBLN_EPS);
            bf16_t* orow = O + (size_t)(mq0_c + i16) * D + h_c * 256 + 4 * a;
#pragma unroll
            for (int d = 0; d < 16; ++d) { const f32x4 g4 = *(const f32x4*)(subln + d * 16 + 4 * a); const f32x4 v = o[d] * g4 * r;
                u32x2 w; w.x = pg8::cvt_pk_bf16(v.x, v.y); w.y = pg8::cvt_pk_bf16(v.z, v.w); *(u32x2*)(orow + d * 16) = w; }
        }
        if (!has_next) break;
        u = un;
      }
    }
#undef ATT_STAGE
#undef ATT_STAGE_B
#undef ATT_SETUP
    LDS_WAIT(); __builtin_amdgcn_s_barrier(); asm volatile("" ::: "memory");
}

constexpr int N_PHASES = 14;
__global__ void __launch_bounds__(NWAVES * 64, 2) mk_fwd(Args args) {
    extern __shared__ __attribute__((aligned(16))) unsigned char lds_raw[];
    Frame F;
    F.lds = (LAS unsigned char*)lds_raw;
    F.tid = threadIdx.x; F.lane = F.tid & 63; F.wave = __builtin_amdgcn_readfirstlane(F.tid >> 6);
    F.G = gridDim.x; { const int bx = blockIdx.x; F.vcu = (F.G % 8 == 0) ? (bx % 8) * (F.G / 8) + bx / 8 : bx; }
    unsigned char* ws = args.ws;
    const int lo = args.ph_lo, hi = args.ph_hi;
    bf16_t* XN = (bf16_t*)(ws + WS_XN); bf16_t* ACT = (bf16_t*)(ws + WS_ACT); float* Y = (float*)(ws + WS_Y);
#define IN(k) (lo <= (k) && (k) < hi)
    volatile LAS unsigned* MISC = (volatile LAS unsigned*)(F.lds + MISC_OFF);
    if (F.tid < 4) MISC[F.tid] = 0u;
    __syncthreads();
    if (hi - lo > 1) (void)xcd_barrier_post((unsigned*)(ws + WS_BAR), MISC);
    if (lo < 0) cg::this_grid().sync();
#define SEAM(k) do { if (IN(k) && IN((k) + 1)) { grid_barrier(ws, F.lds); } } while (0)
#define GEMM_RUN(EPI, epi, Aptr, Bptr, N_, K_, lda_, ldb_, agrp_, M_) do { pg8::Gemm g{(Aptr), (Bptr), (M_), (N_), (K_), (lda_), (ldb_), (agrp_)}; pg8::StaticOrder S; S.init((M_), (N_), F.G, (int)blockIdx.x); \
        pg8::gemm_phase<EPI, pg8::StaticOrder, true>(F.lds, g, S, (epi)); } while (0)
#define RSL(k) ((const float*)(ws + WS_SLOTS + (size_t)(k) * SZ_SLOT))
#define FFN_G1(lf, rk) do { pg8::EpiSwiGLU e{ACT, DFF, RSL(rk)}; GEMM_RUN(pg8::EpiSwiGLU, e, XN, (const bf16_t*)(ws + WS_WGU + (lf) * SZ_WGU), 2 * DFF, D, D, D, 0, M); } while (0)
#define FFN_G2(lf) do { pg8::EpiF32 e{Y, D}; GEMM_RUN(pg8::EpiF32, e, ACT, (const bf16_t*)(ws + WS_WD + (lf) * SZ_WD), D, DFF, DFF, DFF, 0, M); } while (0)

#define PH(k, ...) do { if (IN(k)) { for (int _r = 0; _r <= (int)((DUP_MASK >> (k)) & 1u); ++_r) { if (_r) grid_barrier(ws, F.lds); __VA_ARGS__ } } SEAM(k); } while (0)
#define FUSED_TAIL(idx, xin_, l_, sub_, coef_, last_) EpiNormRes e{args.x, args.out, args.norm_gains, ws, (idx), (((l_) * 3 + (sub_)) * 2 + 1) * D, ((idx) == 0), (last_), (coef_)}
#define FFN_G2F(lf, idx, xin_, l_, sub_, last_) do { FUSED_TAIL(idx, xin_, l_, sub_, 0.5f, last_); GEMM_RUN(EpiNormRes, e, ACT, (const bf16_t*)(ws + WS_WD + (lf) * SZ_WD), D, DFF, DFF, DFF, 0, M); } while (0)
    PH(0, p0_prologue(F, args););
    PH(1, FFN_G1(0, 12); convert_wd_idle(F, args, 0, 1 | 2););
    PH(2, FFN_G2F(0, 0, args.x, 0, 0, 0););
    PH(3, pool_phase(F, XN, RSL(1), (bf16_t*)(ws + WS_DP)););
    PH(4, { FUSED_TAIL(1, args.out, 0, 1, 1.0f, 0); GEMM_RUN(EpiNormRes, e, (const bf16_t*)(ws + WS_DP), (const bf16_t*)(ws + WS_POOL), D, 512, D, 512, 1, M); });
    PH(5, FFN_G1(1, 3); convert_wd_idle(F, args, 1, 4););
    PH(6, FFN_G2F(1, 2, args.out, 0, 2, 0););
    PH(7, { pg8::EpiBf16<1> e{(bf16_t*)(ws + WS_K), D, 1.0f, RSL(5)}; GEMM_RUN(pg8::EpiBf16<1>, e, XN, (const bf16_t*)(ws + WS_WK), D, D, D, D, 0, M); }
          { pg8::EpiBf16<2> e{(bf16_t*)(ws + WS_VT), M, 1.0f, RSL(5)}; GEMM_RUN(pg8::EpiBf16<2>, e, (const bf16_t*)(ws + WS_WV), XN, M, D, D, D, 0, D); }
          FFN_G1(2, 5); convert_wd_idle(F, args, 2, 8 | 16););
    PH(8, FFN_G2F(2, 3, args.out, 1, 0, 0););
    PH(9, { pg8::EpiBf16<1> e{(bf16_t*)(ws + WS_Q), D, QSCALE, RSL(7)}; GEMM_RUN(pg8::EpiBf16<1>, e, XN, (const bf16_t*)(ws + WS_WQ), D, D, D, D, 0, M); });
    PH(10, attn_phase<0>(F, (const bf16_t*)(ws + WS_Q), (const bf16_t*)(ws + WS_K), (const bf16_t*)(ws + WS_VT), (bf16_t*)(ws + WS_O), (const float*)(ws + WS_LUT), args.subln););
    PH(11, { FUSED_TAIL(4, args.out, 1, 1, 1.0f, 0); GEMM_RUN(EpiNormRes, e, (const bf16_t*)(ws + WS_O), (const bf16_t*)(ws + WS_WO), D, D, D, D, 0, M); });
    PH(12, FFN_G1(3, 9); convert_wd_idle(F, args, 3, 0););
    PH(13, FFN_G2F(3, 5, args.out, 1, 2, 1););
}

extern "C" void kernel_launch(void* const* d_in, const int* in_sizes, int n_in, void* d_out, int out_size, void* d_ws, size_t ws_size, hipStream_t stream) {
    static int grid = 0;
    if (grid == 0) {
        if (n_in != 15 || in_sizes[0] != M * D || out_size != M * D || ws_size < WS_END) { fprintf(stderr, "kernel_launch: unexpected shapes (n_in %d in0 %d out %d ws %zu need %zu)\n", n_in, n_in > 0 ? in_sizes[0] : -1, out_size, ws_size, (size_t)WS_END); grid = -1; return; }
        int dev = 0, cus = 0, per_cu = 0;
        hipGetDevice(&dev); hipDeviceGetAttribute(&cus, hipDeviceAttributeMultiprocessorCount, dev);
        if (hipFuncSetAttribute((const void*)mk_fwd, hipFuncAttributeMaxDynamicSharedMemorySize, LDS_BYTES) != hipSuccess) { fprintf(stderr, "kernel_launch: hipFuncSetAttribute failed\n"); grid = -1; return; }
        if (hipOccupancyMaxActiveBlocksPerMultiprocessor(&per_cu, (const void*)mk_fwd, NWAVES * 64, LDS_BYTES) != hipSuccess || per_cu < 1) { fprintf(stderr, "kernel_launch: occupancy query says %d\n", per_cu); per_cu = 1; }
        (void)hipGetLastError();
        grid = cus * per_cu;
        if (grid != 256) { fprintf(stderr, "kernel_launch: this kernel is built for a 256-workgroup resident grid (one per CU), got %d; nothing launched\n", grid); grid = -1; return; }
        fprintf(stderr, "kernel_launch: grid %d (cus %d x %d)\n", grid, cus, per_cu);
    }
    if (grid < 0) return;
    Args a{};
    a.x = (const float*)d_in[0]; a.norm_gains = (const float*)d_in[1]; a.wg = (const float*)d_in[2]; a.wu = (const float*)d_in[3]; a.wd = (const float*)d_in[4];
    a.pool_w = (const float*)d_in[5]; a.pool_scale = (const float*)d_in[6]; a.kv_norm = (const float*)d_in[7]; a.w_k = (const float*)d_in[8]; a.w_v = (const float*)d_in[9];
    a.rel_bias = (const float*)d_in[10]; a.w_q = (const float*)d_in[11]; a.w_o = (const float*)d_in[12]; a.lambdas = (const float*)d_in[13]; a.subln = (const float*)d_in[14];
    a.out = (float*)d_out; a.ws = (unsigned char*)d_ws;
    if (hipMemsetAsync((char*)d_ws + WS_BAR, 0, BAR_BYTES, stream) != hipSuccess) { fprintf(stderr, "kernel_launch: memset failed\n"); return; }
#if MK_MULTI
    for (int p = 0; p < N_PHASES; ++p) { a.ph_lo = p; a.ph_hi = p + 1; hipLaunchKernelGGL(mk_fwd, dim3(grid), dim3(NWAVES * 64), LDS_BYTES, stream, a); }
#else
    a.ph_lo = 0; a.ph_hi = N_PHASES;
    void* kargs[] = {&a};
    hipError_t e = hipLaunchCooperativeKernel((const void*)mk_fwd, dim3(grid), dim3(NWAVES * 64), kargs, LDS_BYTES, stream);
    if (e != hipSuccess) fprintf(stderr, "kernel_launch: cooperative launch failed: %s (grid %d)\n", hipGetErrorString(e), grid);
#endif
}
```
